# Optimizing an MI355X kernel written in HIP

```python
import jax, jax.numpy as jnp
from jax import lax
import numpy as np

D_MODEL = 2048
BATCH = 4
SEQ = 4096
DEPTH = 2

N_MIXERS = 2
N_CONV_LAYERS = (DEPTH + 1) // 2
N_ATTN_LAYERS = DEPTH // 2
N_META = 16
CONV_WIDTH = 3
N_HEADS = 16
HEAD_DIM = D_MODEL // N_HEADS
Q_BLOCK = 128
N_GROUPS = 4
EXPERTS_PER_GROUP = 8
N_EXPERTS = N_GROUPS * EXPERTS_PER_GROUP
TOP_K = 2
D_EXPERT = D_MODEL // 4
EPS = 1e-6

kernel_name = "hybrid_shortconv_stickbreaking_hmoe"


def rms_norm(x, g):
    x32 = x.astype(jnp.float32)
    y = x32 * lax.rsqrt(jnp.mean(x32 * x32, axis=-1, keepdims=True) + EPS)
    return (y * g.astype(jnp.float32)).astype(x.dtype)


def short_conv_mixer(xn, w_in, w_conv, w_out):
    L = xn.shape[1]
    b_gate, c_gate, h = jnp.split(xn @ w_in, 3, axis=-1)
    v = c_gate * h
    vp = jnp.pad(v, ((0, 0), (CONV_WIDTH - 1, 0), (0, 0)))
    y = w_conv[0] * vp[:, 0:L]
    for k in range(1, CONV_WIDTH):
        y = y + w_conv[k] * vp[:, k:k + L]
    return (b_gate * y) @ w_out


def stick_breaking_attention(xn, w_qkv, w_out):
    Bsz, L, _ = xn.shape
    pad = (-N_META) % Q_BLOCK
    qkv = (xn @ w_qkv).reshape(Bsz, L, 3, N_HEADS, HEAD_DIM)
    qkv = jnp.pad(qkv, ((0, 0), (pad, 0), (0, 0), (0, 0), (0, 0)))
    qkv = qkv.transpose(2, 0, 3, 1, 4)
    q, k, v = qkv[0], qkv[1], qkv[2]
    Lp = L + pad
    scale = HEAD_DIM ** -0.5
    outs = []
    for blk in range(Lp // Q_BLOCK):
        q0 = blk * Q_BLOCK
        kend = q0 + Q_BLOCK
        qb = q[:, :, q0:kend]
        kb = k[:, :, :kend]
        vb = v[:, :, :kend]
        z = jnp.einsum('bhqd,bhkd->bhqk', qb, kb).astype(jnp.float32) * scale
        t_pos = q0 + jnp.arange(Q_BLOCK)[:, None]
        s_pos = jnp.arange(kend)[None, :]
        mask = (s_pos < t_pos) & (s_pos >= pad)
        log_1m = jnp.where(mask, jax.nn.log_sigmoid(-z), 0.0)
        rest = lax.cumsum(log_1m, axis=3, reverse=True) - log_1m
        a = jnp.where(mask, jnp.exp(jax.nn.log_sigmoid(z) + rest), 0.0)
        outs.append(jnp.einsum('bhqk,bhkd->bhqd', a.astype(vb.dtype), vb))
    o = jnp.concatenate(outs, axis=2)[:, :, pad:]
    o = o.transpose(0, 2, 1, 3).reshape(Bsz, L, D_MODEL)
    return o @ w_out


def hierarchical_moe(xn, wg_r, bg_r, we_r, be_r, w_gate, w_up, w_down):
    Bsz, L, D = xn.shape
    xt = xn.reshape(-1, D)
    n_tok = xt.shape[0]
    group_logits = (xt @ wg_r).astype(jnp.float32) + bg_r.astype(jnp.float32)
    p_group = jax.nn.softmax(group_logits, axis=-1)
    p_top, g_sel = lax.top_k(p_group, 1)
    exp_logits = ((xt @ we_r).astype(jnp.float32) + be_r.astype(jnp.float32)).reshape(
        n_tok, N_GROUPS, EXPERTS_PER_GROUP)
    sel_logits = jnp.take_along_axis(exp_logits, g_sel[:, :, None], axis=1)[:, 0]
    top_val, top_idx = lax.top_k(sel_logits, TOP_K)
    gate = jax.nn.softmax(top_val, axis=-1) * p_top
    e_idx = g_sel * EXPERTS_PER_GROUP + top_idx
    combine = jnp.sum(jax.nn.one_hot(e_idx, N_EXPERTS, dtype=jnp.float32) * gate[..., None], axis=1)
    combine = combine.astype(xt.dtype)
    out = jnp.zeros_like(xt)
    for g in range(N_GROUPS):
        sl = slice(g * EXPERTS_PER_GROUP, (g + 1) * EXPERTS_PER_GROUP)
        hg = jax.nn.silu(jnp.einsum('nd,edf->nef', xt, w_gate[sl])) * jnp.einsum('nd,edf->nef', xt, w_up[sl])
        out = out + jnp.einsum('nef,efd->nd', hg * combine[:, sl, None], w_down[sl])
    return out.reshape(Bsz, L, D)


def setup_inputs(seed: int = 0) -> dict:
    key = jax.random.key(seed)
    ks = jax.random.split(key, 20)
    D, F, E, G = D_MODEL, D_EXPERT, N_EXPERTS, N_GROUPS
    nrm = jax.random.normal
    f32 = jnp.float32
    return {
        "x": nrm(ks[0], (BATCH, SEQ, D), f32),
        "meta_tokens": nrm(ks[1], (N_META, D), f32),
        "norm_mix_g": 1.0 + 0.02 * nrm(ks[2], (DEPTH, D), f32),
        "norm_ffn_g": 1.0 + 0.02 * nrm(ks[3], (DEPTH, D), f32),
        "conv_w_in": nrm(ks[4], (N_CONV_LAYERS, D, 3 * D), f32) * D ** -0.5,
        "conv_w": nrm(ks[5], (N_CONV_LAYERS, CONV_WIDTH, D), f32) * CONV_WIDTH ** -0.5,
        "conv_w_out": nrm(ks[6], (N_CONV_LAYERS, D, D), f32) * D ** -0.5,
        "attn_w_qkv": nrm(ks[7], (N_ATTN_LAYERS, D, 3 * D), f32) * D ** -0.5,
        "attn_w_out": nrm(ks[8], (N_ATTN_LAYERS, D, D), f32) * D ** -0.5,
        "router_group_w": nrm(ks[9], (DEPTH, D, G), f32) * D ** -0.5,
        "router_group_b": 0.01 * nrm(ks[10], (DEPTH, G), f32),
        "router_expert_w": nrm(ks[11], (DEPTH, D, E), f32) * D ** -0.5,
        "router_expert_b": 0.01 * nrm(ks[12], (DEPTH, E), f32),
        "moe_w_gate": nrm(ks[13], (DEPTH, E, D, F), f32) * D ** -0.5,
        "moe_w_up": nrm(ks[14], (DEPTH, E, D, F), f32) * D ** -0.5,
        "moe_w_down": nrm(ks[15], (DEPTH, E, F, D), f32) * F ** -0.5,
        "final_norm_g": 1.0 + 0.02 * nrm(ks[16], (D,), f32),
    }


def reference(x, meta_tokens, norm_mix_g, norm_ffn_g, conv_w_in, conv_w, conv_w_out,
              attn_w_qkv, attn_w_out, router_group_w, router_group_b, router_expert_w,
              router_expert_b, moe_w_gate, moe_w_up, moe_w_down, final_norm_g):
    Bsz = x.shape[0]
    meta = jnp.broadcast_to(meta_tokens[None].astype(x.dtype), (Bsz, N_META, D_MODEL))
    h = jnp.concatenate([meta, x], axis=1)
    for i in range(DEPTH):
        xn = rms_norm(h, norm_mix_g[i])
        j = i // N_MIXERS
        if i % N_MIXERS == 0:
            h = h + short_conv_mixer(xn, conv_w_in[j], conv_w[j], conv_w_out[j])
        else:
            h = h + stick_breaking_attention(xn, attn_w_qkv[j], attn_w_out[j])
        h = h + hierarchical_moe(rms_norm(h, norm_ffn_g[i]), router_group_w[i], router_group_b[i],
                                 router_expert_w[i], router_expert_b[i],
                                 moe_w_gate[i], moe_w_up[i], moe_w_down[i])
    return rms_norm(h, final_norm_g)[:, N_META:]
```

```cpp
#include <hip/hip_runtime.h>
#include <cstdio>
#include <cstdint>

#ifndef MK_N_LAUNCHES
#define MK_N_LAUNCHES 1
#endif
#ifndef ATTN_EARLY_EXIT
#define ATTN_EARLY_EXIT 1
#endif

#ifndef PROBE_DUP
#define PROBE_DUP 0
#endif
#define GAS __attribute__((address_space(1)))
#define LAS __attribute__((address_space(3)))
typedef unsigned short bf16;
typedef short bf16x8 __attribute__((ext_vector_type(8)));
typedef short s16x4 __attribute__((ext_vector_type(4)));
typedef float f32x4 __attribute__((ext_vector_type(4)));
typedef float f32x16 __attribute__((ext_vector_type(16)));
typedef unsigned u32x4 __attribute__((ext_vector_type(4)));
typedef unsigned u32x2 __attribute__((ext_vector_type(2)));
typedef float f32x2_t __attribute__((ext_vector_type(2)));
typedef __bf16 bf16x2_t __attribute__((ext_vector_type(2)));
typedef GAS unsigned gu32;
typedef int v4i_t __attribute__((ext_vector_type(4)));
typedef int v8i_t __attribute__((ext_vector_type(8)));

constexpr int D = 2048, NB = 4, T = 4096, NMETA = 16, M = NB * T, MT = M + NMETA, NH = 16, HD = 128;
constexpr int NE = 32, NG = 4, EPG = 8, F = 512, CAP = 16640;
constexpr float EPS = 1e-6f;
constexpr float QSCALE = 0.08838834764831845f * 1.4426950408889634f;
constexpr int NPH = 15;
constexpr int NWAVES = 8;

constexpr size_t MiB = 1u << 20;
constexpr size_t WS_CTL = 0, CTL_ZERO_BYTES = 1 * MiB;
constexpr size_t WS_WIN0 = 2 * MiB, WS_WOUT0 = 26 * MiB, WS_WQKV = 34 * MiB, WS_WOUT1 = 58 * MiB;
constexpr size_t WS_WGU0 = 66 * MiB, WS_WD0 = 194 * MiB, WS_WGU1 = 258 * MiB, WS_WD1 = 386 * MiB;
constexpr size_t WS_RW = 450 * MiB;
constexpr size_t WS_XN = 452 * MiB;
constexpr size_t WS_R0 = 517 * MiB, WS_R1 = 582 * MiB, WS_R2 = 647 * MiB;
constexpr size_t WS_H = 712 * MiB;
constexpr size_t WS_HG = 841 * MiB;
constexpr size_t WS_LTOK = 882 * MiB, WS_LGATE = 885 * MiB, WS_LRSTD = 888 * MiB;
constexpr size_t WS_MSCR = 891 * MiB;
constexpr size_t WS_END = 892 * MiB;
static_assert((size_t)MT * D * 2 <= 65 * MiB && (size_t)MT * D * 4 <= 129 * MiB && (size_t)40992 * 512 * 2 <= 41 * MiB && (size_t)NE * CAP * 4 <= 3 * MiB, "ws map");
constexpr int CW_TMO = 0;
constexpr int CW_BAR = 4096;
constexpr int CW_CNT = 16384;
constexpr int RING_BYTES = 150528, LDSCTL_OFF = RING_BYTES, MISC_OFF = LDSCTL_OFF + 320, GTAB_OFF = MISC_OFF + 128, LDS_BYTES = 151552, HOST_OFF = 131072, HOST_TAB_OFF = 147456, HOST_TAB_MAX = 160;
static_assert(GTAB_OFF + 512 <= LDS_BYTES, "lds map");

#define RLX_AGENT __ATOMIC_RELAXED, __HIP_MEMORY_SCOPE_AGENT
#define LDS_WAIT() asm volatile("s_waitcnt lgkmcnt(0)" ::: "memory")
#define VM_WAIT() asm volatile("s_waitcnt vmcnt(0)" ::: "memory")

__device__ __forceinline__ unsigned pk2(float lo, float hi) { f32x2_t v = {lo, hi}; bf16x2_t b = __builtin_convertvector(v, bf16x2_t); return __builtin_bit_cast(unsigned, b); }
__device__ __forceinline__ unsigned pk4_fp8(float a, float b, float c, float d) { int w = __builtin_amdgcn_cvt_pk_fp8_f32(a, b, 0, false); w = __builtin_amdgcn_cvt_pk_fp8_f32(c, d, w, true); return (unsigned)w; }
__device__ __forceinline__ size_t t64_off(size_t row, int cb) { return ((((row >> 4) * (size_t)(D * 2 / 64)) + (size_t)(cb >> 6)) << 10) + ((row & 15) << 6) + (cb & 63); }
__device__ __forceinline__ size_t qkv_off(size_t row, int col) { return ((row >> 2) * 256 + (size_t)(col >> 3)) * 32 + (row & 3) * 8 + (col & 7); }
__device__ __forceinline__ float bf2f(unsigned short u) { return __uint_as_float(((unsigned)u) << 16); }
__device__ __forceinline__ float bflo(unsigned u) { return __uint_as_float(u << 16); }
__device__ __forceinline__ float bfhi(unsigned u) { return __uint_as_float(u & 0xffff0000u); }
__device__ __forceinline__ int opaque_tid() { int t = (int)threadIdx.x; asm volatile("" : "+v"(t)); return t; }
__device__ __forceinline__ float wave_sum(float v) {
#pragma unroll
    for (int o = 1; o < 64; o <<= 1) v += __shfl_xor(v, o);
    return v;
}


struct HostJob { int layer, first, stride, i0, n; };
struct HostItem { const float* src; unsigned char* dst; int N, K; };
__device__ __forceinline__ HostItem host_item(const HostJob& hj, int i);
namespace pg8 {
constexpr int BM = 256, BK = 64, HALF = 128, HTB = HALF * BK * 2, STAGE_BYTES = 8 * HTB, NXCD = 8, WGM = 4;
__host__ __device__ __forceinline__ int lds_byte(int r, int c) { const int st = (r >> 4) * 2 + (c >> 5), rr = r & 15, cc = c & 31, ob = rr * 64 + cc * 2; return st * 1024 + (ob ^ (((ob >> 9) & 1) << 5)); }
__host__ __device__ __forceinline__ void stage_rc(int b, int& R, int& C) { const int st = b / 1024, sb = b % 1024, swz = sb ^ (((sb >> 9) & 1) << 5); R = (st >> 1) * 16 + swz / 64; C = (st & 1) * 32 + (swz % 64) / 2; }
__host__ __device__ __forceinline__ int perm32(int rho) { const int n = rho >> 4, i = rho & 15; return 8 * (i >> 2) + 4 * n + (i & 3); }

struct Unit { int pm, pn, e, rows, rb, li; };

__device__ __forceinline__ int xcd_remap(int L, int nwg) { const int q = nwg / NXCD, r = nwg % NXCD, xcd = L % NXCD, off = L / NXCD; return (xcd < r ? xcd * (q + 1) : r * (q + 1) + (xcd - r) * q) + off; }

template <bool TILED> struct DenseOrderT {
    static constexpr bool VAR_A = false;
    const bf16* A; const bf16* Bt; int K, rowb, wscale, nM, nN, nwg, G, c;
    __device__ __forceinline__ void init(const bf16* A_, const bf16* Bt_, int Mrows, int N, int K_, int G_, int c_, int esz = 2) { A = A_; Bt = Bt_; K = K_; rowb = K_ * esz; wscale = 0; nM = Mrows / BM; nN = N / BM; nwg = nM * nN; G = G_; c = c_; }
    __device__ __forceinline__ bool next(int i, Unit& u) const {
        const long L = (long)i * G + c; if (L >= nwg) return false;
        const int wgid = xcd_remap((int)L, nwg);
        const int nig = WGM * nN, gid = wgid / nig, fm = gid * WGM, gsz = (nM - fm) < WGM ? (nM - fm) : WGM;
        u.pm = fm + ((wgid % nig) % gsz); u.pn = (wgid % nig) / gsz; u.e = 0; u.rows = BM; u.rb = u.pm * BM; u.li = i; return true;
    }
    __device__ __forceinline__ size_t kstep_a() const { return TILED ? (size_t)2048 : (size_t)(BK * 2); }
    __device__ __forceinline__ const char* a_base(const Unit& u) const { return (const char*)A + (size_t)u.pm * BM * rowb; }
    __device__ __forceinline__ const char* b_base(const Unit& u) const { return (const char*)Bt + (size_t)u.pn * BM * rowb; }
    __device__ __forceinline__ void a_off(const Unit&, const int (&R)[2], const int (&C)[2], unsigned (&v)[2][2]) const {
#pragma unroll
        for (int h = 0; h < 2; ++h)
#pragma unroll
            for (int i = 0; i < 2; ++i) { const int r = R[i] + HALF * h; v[h][i] = TILED ? (unsigned)((((r >> 4) * (rowb >> 6) + (C[i] >> 5)) << 10) + ((r & 15) << 6) + ((C[i] * 2) & 63)) : (unsigned)(r * rowb + C[i] * 2); }
    }
};
using DenseOrder = DenseOrderT<false>;
template <bool GATHER> struct GroupedOrder {
    static constexpr bool VAR_A = GATHER;
    __device__ __forceinline__ size_t kstep_a() const { return (size_t)(BK * 2); }
    const void* A; const void* Bt; const int* ltok; const LAS int* tab; const LAS int* tokl; int K, rowb, wscale, NCT, nunits, G, c; size_t bstride;
    __device__ __forceinline__ bool next(int i, Unit& u) const {
        const long L = (long)i * G + c; if (L >= nunits) return false;
        const int wgid = xcd_remap((int)L, nunits);
        const int tl = wgid / NCT; u.pn = wgid % NCT;
        const int ln = (int)(threadIdx.x & 31);
        const int e = __builtin_popcountll(__ballot((threadIdx.x & 63) < 32 && tab[32 + ln] <= tl)) - 1;
        u.e = e; u.pm = tl - tab[32 + e]; const int rem = tab[e] - BM * u.pm; u.rows = rem < BM ? rem : BM; u.rb = tl * BM; u.li = i; return true;
    }
    __device__ __forceinline__ const char* a_base(const Unit& u) const { return GATHER ? (const char*)A : (const char*)A + (size_t)u.rb * rowb; }
    __device__ __forceinline__ const char* b_base(const Unit& u) const { return (const char*)Bt + (size_t)u.e * bstride + (size_t)u.pn * BM * rowb; }
    __device__ __forceinline__ void a_off(const Unit& u, const int (&R)[2], const int (&C)[2], unsigned (&v)[2][2]) const {
#pragma unroll
        for (int h = 0; h < 2; ++h)
#pragma unroll
            for (int i = 0; i < 2; ++i) {
                const int r = R[i] + HALF * h;
                if (GATHER) { const int tok = tokl[u.li * BM + r]; v[h][i] = (unsigned)(tok * rowb + C[i] * 2); }
                else v[h][i] = (unsigned)(r * rowb + C[i] * 2);
            }
    }
};

template <class S> __device__ __forceinline__ void prefill_tokens(const S& sch, LAS int* tokl, LAS float* fl, const float* fsrc, int maxu, bool keepk) {
    Unit u;
    for (int i = 0; i < maxu && sch.next(i, u); ++i)
        for (int r = (int)threadIdx.x; r < BM; r += NWAVES * 64) { const size_t li = (size_t)u.e * CAP + u.pm * BM + r; const bool ok = r < u.rows;
            const int tk = ok ? sch.ltok[li] : 0; tokl[i * BM + r] = keepk ? tk : (tk & 0x7fffffff); fl[i * BM + r] = ok ? fsrc[li] : 0.f; }
    __syncthreads();
}
struct EpiCH {
    static constexpr bool PERM = true;
    bf16* V1;
    __device__ __forceinline__ void operator()(const f32x4 (&acc)[2][2][4][2], const Unit& u, int wr, int wc, int fr, int fq) const {
        const int row0 = u.pm * BM + wr * 64 + fr, col0 = u.pn * HALF + wc * 32 + 8 * fq;
#pragma unroll
        for (int ai = 0; ai < 2; ++ai)
#pragma unroll
            for (int m = 0; m < 4; ++m) { bf16* rowp = (bf16*)((unsigned char*)V1 + t64_off((size_t)(row0 + ai * HALF + m * 16), col0 * 2));
                const f32x4 v0 = acc[ai][0][m][0] * acc[ai][1][m][0], v1 = acc[ai][0][m][1] * acc[ai][1][m][1]; u32x4 w; w.x = pk2(v0[0], v0[1]); w.y = pk2(v0[2], v0[3]); w.z = pk2(v1[0], v1[1]); w.w = pk2(v1[2], v1[3]);
                *(u32x4*)rowp = w; }
    }
};
struct EpiGateConv {
    static constexpr bool PERM = true;
    const bf16* V1; bf16* U; const float* cw; const float* mscr;
    __device__ __forceinline__ void ld8(const bf16* p, float (&o)[8]) const { const u32x4 q = *(const u32x4*)p; o[0] = bflo(q.x); o[1] = bfhi(q.x); o[2] = bflo(q.y); o[3] = bfhi(q.y); o[4] = bflo(q.z); o[5] = bfhi(q.z); o[6] = bflo(q.w); o[7] = bfhi(q.w); }
    __device__ __forceinline__ void meta8(int i, int c0, float (&o)[8]) const {
#pragma unroll
        for (int j = 0; j < 8; ++j) { const int c = c0 + j; const float cv = mscr[i * (3 * D) + D + (c >> 7) * 256 + (c & 127)], hv = mscr[i * (3 * D) + D + (c >> 7) * 256 + 128 + (c & 127)]; o[j] = bf2f((unsigned short)(pk2(cv * hv, 0.f) & 0xffffu)); }
    }
    __device__ __forceinline__ void operator()(const f32x4 (&acc)[2][2][4][2], const Unit& u, int wr, int wc, int fr, int fq) const {
#pragma unroll
        for (int bj = 0; bj < 2; ++bj) {
            const int c0 = u.pn * BM + bj * HALF + wc * 32 + 8 * fq;
            float w0[8], w1[8], w2[8];
#pragma unroll
            for (int j = 0; j < 8; ++j) { w0[j] = cw[c0 + j]; w1[j] = cw[D + c0 + j]; w2[j] = cw[2 * D + c0 + j]; }
#pragma unroll
            for (int ai = 0; ai < 2; ++ai) {
                __builtin_amdgcn_sched_barrier(0);
                const int rb = u.pm * BM + wr * 64 + ai * HALF;
                u32x4 q[5];
                if ((rb & (T - 1)) != 0) q[0] = *(const u32x4*)((const unsigned char*)V1 + t64_off((size_t)(rb - 16 + fr), c0 * 2));
                else { q[0] = (u32x4){0u, 0u, 0u, 0u}; if (fr >= 14) { float mv[8]; meta8(fr, c0, mv); q[0].x = pk2(mv[0], mv[1]); q[0].y = pk2(mv[2], mv[3]); q[0].z = pk2(mv[4], mv[5]); q[0].w = pk2(mv[6], mv[7]); } }
#pragma unroll
                for (int m = 0; m < 4; ++m) q[1 + m] = *(const u32x4*)((const unsigned char*)V1 + t64_off((size_t)(rb + m * 16 + fr), c0 * 2));
#pragma unroll
                for (int m = 0; m < 4; ++m) {
                    const int r = rb + m * 16 + fr;
                    const f32x4 b0 = acc[ai][bj][m][0], b1 = acc[ai][bj][m][1]; u32x4 w;
#pragma unroll
                    for (int d = 0; d < 4; ++d) {
                        const unsigned c = q[1 + m][d], p = q[m][d];
                        const unsigned a1 = __builtin_amdgcn_mov_dpp(c, 0x121, 0xf, 0xf, false), p1 = __builtin_amdgcn_mov_dpp(p, 0x121, 0xf, 0xf, false);
                        const unsigned a2 = __builtin_amdgcn_mov_dpp(c, 0x122, 0xf, 0xf, false), p2 = __builtin_amdgcn_mov_dpp(p, 0x122, 0xf, 0xf, false);
                        const unsigned x1 = fr < 1 ? p1 : a1, x2 = fr < 2 ? p2 : a2;
                        const float bl = d < 2 ? b0[2 * d] : b1[2 * d - 4], bh = d < 2 ? b0[2 * d + 1] : b1[2 * d - 3];
                        const float ol = bl * (w0[2 * d] * bflo(x2) + w1[2 * d] * bflo(x1) + w2[2 * d] * bflo(c)), oh = bh * (w0[2 * d + 1] * bfhi(x2) + w1[2 * d + 1] * bfhi(x1) + w2[2 * d + 1] * bfhi(c));
                        w[d] = pk2(ol, oh);
                    }
                    *(u32x4*)((unsigned char*)U + t64_off((size_t)r, c0 * 2)) = w;
                }
            }
        }
    }
};
struct EpiQKV {
    static constexpr bool PERM = true;
    bf16* Q; size_t stride; float qscale;
    __device__ __forceinline__ void operator()(const f32x4 (&acc)[2][2][4][2], const Unit& u, int wr, int wc, int fr, int fq) const {
        const int row0 = u.pm * BM + wr * 64 + fr; const int t = u.pn >> 3; bf16* base = Q + (size_t)t * stride; const float sc = t == 0 ? qscale : 1.f;
        const int col0 = (u.pn & 7) * BM + wc * 32 + 8 * fq;
#pragma unroll
        for (int ai = 0; ai < 2; ++ai)
#pragma unroll
            for (int m = 0; m < 4; ++m) { bf16* rowp = base + qkv_off((size_t)(row0 + ai * HALF + m * 16), col0);
#pragma unroll
                for (int bj = 0; bj < 2; ++bj) { const f32x4 v0 = acc[ai][bj][m][0] * sc, v1 = acc[ai][bj][m][1] * sc; u32x4 w; w.x = pk2(v0[0], v0[1]); w.y = pk2(v0[2], v0[3]); w.z = pk2(v1[0], v1[1]); w.w = pk2(v1[2], v1[3]);
                    *(u32x4*)(rowp + bj * 512) = w; } }
    }
};
template <bool IN_F32> struct EpiResid {
    static constexpr bool PERM = true;
    const void* in; bf16* out;
    __device__ __forceinline__ void operator()(const f32x4 (&acc)[2][2][4][2], const Unit& u, int wr, int wc, int fr, int fq) const {
        const int row0 = u.pm * BM + wr * 64 + fr, col0 = u.pn * BM + wc * 32 + 8 * fq;
        constexpr int GM = IN_F32 ? 2 : 4;
#pragma unroll
        for (int ai = 0; ai < 2; ++ai)
#pragma unroll
            for (int mg = 0; mg < 4; mg += GM) {
                __builtin_amdgcn_sched_barrier(0);
                u32x4 ra[GM][2], rb[GM][2];
#pragma unroll
                for (int mm = 0; mm < GM; ++mm)
#pragma unroll
                    for (int bj = 0; bj < 2; ++bj) { const size_t off = (size_t)(row0 + ai * HALF + (mg + mm) * 16) * D + col0 + bj * HALF;
                        if (IN_F32) { ra[mm][bj] = *(const u32x4*)((const float*)in + off); rb[mm][bj] = *(const u32x4*)((const float*)in + off + 4); }
                        else { ra[mm][bj] = *(const u32x4*)((const bf16*)in + off); rb[mm][bj] = ra[mm][bj]; } }
                __builtin_amdgcn_sched_barrier(0);
#pragma unroll
                for (int mm = 0; mm < GM; ++mm)
#pragma unroll
                    for (int bj = 0; bj < 2; ++bj) { const size_t off = (size_t)(row0 + ai * HALF + (mg + mm) * 16) * D + col0 + bj * HALF; f32x4 b0, b1; const u32x4 q = ra[mm][bj], q2 = rb[mm][bj];
                        if (IN_F32) { b0 = __builtin_bit_cast(f32x4, q); b1 = __builtin_bit_cast(f32x4, q2); }
                        else { b0 = (f32x4){bflo(q.x), bfhi(q.x), bflo(q.y), bfhi(q.y)}; b1 = (f32x4){bflo(q.z), bfhi(q.z), bflo(q.w), bfhi(q.w)}; }
                        const f32x4 v0 = b0 + acc[ai][bj][mg + mm][0], v1 = b1 + acc[ai][bj][mg + mm][1]; u32x4 w; w.x = pk2(v0[0], v0[1]); w.y = pk2(v0[2], v0[3]); w.z = pk2(v1[0], v1[1]); w.w = pk2(v1[2], v1[3]);
                        *(u32x4*)(out + off) = w; }
            }
    }
};
struct EpiGateUp {
    static constexpr bool PERM = true;
    unsigned char* HG; const LAS float* lrstd;
    __device__ __forceinline__ void operator()(const f32x4 (&acc)[2][2][4][2], const Unit& u, int wr, int wc, int fr, int fq) const {
        const int row0 = u.rb + wr * 64 + fr, col0 = u.pn * HALF + wc * 32 + 8 * fq; const int lb = u.li * BM;
#pragma unroll
        for (int ai = 0; ai < 2; ++ai)
#pragma unroll
            for (int m = 0; m < 4; ++m) { unsigned char* rowp = HG + (size_t)(row0 + ai * HALF + m * 16) * F + col0; float o[8]; const int r = ai * HALF + wr * 64 + m * 16 + fr; const float rs = lrstd[lb + r];
#pragma unroll
                for (int n = 0; n < 2; ++n)
#pragma unroll
                    for (int j = 0; j < 4; ++j) { const float g = acc[ai][0][m][n][j] * rs, up = acc[ai][1][m][n][j] * rs; o[n * 4 + j] = g * __builtin_amdgcn_rcpf(1.f + __builtin_amdgcn_exp2f(-1.4426950408889634f * g)) * up; }
                u32x2 w; w.x = pk4_fp8(o[0], o[1], o[2], o[3]); w.y = pk4_fp8(o[4], o[5], o[6], o[7]); *(u32x2*)rowp = w; }
    }
};
struct EpiDown {
    static constexpr bool PERM = true;
    bf16* Y0; bf16* Y1; const LAS int* ltok; const LAS float* lgate;
    __device__ __forceinline__ void operator()(const f32x4 (&acc)[2][2][4][2], const Unit& u, int wr, int wc, int fr, int fq) const {
        const int col0 = u.pn * BM + wc * 32 + 8 * fq; const int lb = u.li * BM;
#pragma unroll
        for (int ai = 0; ai < 2; ++ai)
#pragma unroll
            for (int m = 0; m < 4; ++m) { const int r = ai * HALF + wr * 64 + m * 16 + fr;
                if (r < u.rows) { const int tk = ltok[lb + r]; const float gt = lgate[lb + r]; bf16* rowp = ((tk < 0) ? Y1 : Y0) + (size_t)(tk & 0x7fffffff) * D + col0;
#pragma unroll
                    for (int bj = 0; bj < 2; ++bj) { const f32x4 v0 = acc[ai][bj][m][0] * gt, v1 = acc[ai][bj][m][1] * gt; u32x4 w; w.x = pk2(v0[0], v0[1]); w.y = pk2(v0[2], v0[3]); w.z = pk2(v1[0], v1[1]); w.w = pk2(v1[2], v1[3]);
                        *(u32x4*)(rowp + bj * HALF) = w; } } }
    }
};

template <class Epi, class Sched, bool ALIGN_EPI, bool FP8 = false, bool HOST = false>
__device__ __forceinline__ int gemm_phase(LAS unsigned char* lds, const Sched& S, const Epi& E, const HostJob* hjp = nullptr) {
    const int tid = opaque_tid(), wid = __builtin_amdgcn_readfirstlane(tid >> 6), lane = tid & 63, wr = wid >> 2, wc = wid & 3, fr = lane & 15, fq = lane >> 4;
    const int rowb = S.rowb, nt = rowb / (BK * 2);
    int RR[2], CC[2]; unsigned voffB[2];
#pragma unroll
    for (int i = 0; i < 2; ++i) { int R, C; stage_rc(tid * 16 + i * 8192, R, C); RR[i] = R; CC[i] = C; const int Rb = Epi::PERM ? ((R & ~31) + perm32(R & 31)) : R; voffB[i] = (unsigned)(Rb * rowb + C * 2); }
    const size_t kstep = (size_t)(BK * 2), kstepA = S.kstep_a();
    const size_t hstep = (size_t)HALF * rowb;
    const unsigned ldsw = (unsigned)wid * 1024u;
    const int aoff = FP8 ? lds_byte(wr * 64 + fr, (fq >> 1) * 32 + (fq & 1) * 16) : lds_byte(wr * 64 + fr, fq * 8), boff = FP8 ? lds_byte(wc * 32 + fr, (fq >> 1) * 32 + (fq & 1) * 16) : lds_byte(wc * 32 + fr, fq * 8);
#define PG8_SA(b, h) (((b) * 2 + (h)) * HTB)
#define PG8_SB(b, h) ((4 + (b) * 2 + (h)) * HTB)
#define PG8_STAGE(bufoff, gbase, voff) do { _Pragma("unroll") for (int _i = 0; _i < 2; ++_i) \
        __builtin_amdgcn_global_load_lds((const unsigned*)((const char*)(gbase) + (voff)[_i]), (LAS unsigned*)(lds + (bufoff) + ldsw + _i * 8192), 16, 0, 0); } while (0)
#define PG8_LDA(dst, b, h) do { _Pragma("unroll") for (int m = 0; m < 4; ++m) _Pragma("unroll") for (int k = 0; k < 2; ++k) dst[m][k] = *(const LAS bf16x8*)(lds + PG8_SA(b, h) + aoff + m * 2048 + (FP8 ? k * 16 : k * 1024)); } while (0)
#define PG8_LDB(dst, b, h) do { _Pragma("unroll") for (int n = 0; n < 2; ++n) _Pragma("unroll") for (int k = 0; k < 2; ++k) dst[n][k] = *(const LAS bf16x8*)(lds + PG8_SB(b, h) + boff + n * 2048 + (FP8 ? k * 16 : k * 1024)); } while (0)
#define PG8_CAT8(x) __builtin_shufflevector(__builtin_bit_cast(v4i_t, x[0]), __builtin_bit_cast(v4i_t, x[1]), 0, 1, 2, 3, 4, 5, 6, 7)
#define PG8_MMA(ai, bj, At, Bt) do { __builtin_amdgcn_s_setprio(1); \
        if constexpr (FP8) { _Pragma("unroll") for (int m = 0; m < 4; ++m) _Pragma("unroll") for (int n = 0; n < 2; ++n) \
            asm("v_mfma_scale_f32_16x16x128_f8f6f4 %0, %1, %2, %0, %3, %3 op_sel_hi:[0,0,0]" : "+v"(acc[ai][bj][m][n]) : "v"(PG8_CAT8(Bt[n])), "v"(PG8_CAT8(At[m])), "v"(sc8)); } \
        else { _Pragma("unroll") for (int m = 0; m < 4; ++m) _Pragma("unroll") for (int n = 0; n < 2; ++n) _Pragma("unroll") for (int k = 0; k < 2; ++k) \
            acc[ai][bj][m][n] = __builtin_amdgcn_mfma_f32_16x16x32_bf16(Bt[n][k], At[m][k], acc[ai][bj][m][n], 0, 0, 0); } \
        __builtin_amdgcn_s_setprio(0); } while (0)
#define PG8_WAIT_V(n) asm volatile("s_waitcnt vmcnt(" #n ")" ::: "memory")
#define PG8_WAIT_L(n) asm volatile("s_waitcnt lgkmcnt(" #n ")" ::: "memory")
#define PG8_BAR __builtin_amdgcn_s_barrier()
#define PG8_SCHED __builtin_amdgcn_sched_barrier(0)
    Unit cur, nxt; int ui = 0;
    if (!S.next(0, cur)) return 0;
    const int sc8 = 0x7d7d7d7d;
    f32x4 acc[2][2][4][2];
#pragma unroll
    for (int a = 0; a < 2; ++a)
#pragma unroll
        for (int b = 0; b < 2; ++b)
#pragma unroll
            for (int m = 0; m < 4; ++m)
#pragma unroll
                for (int n = 0; n < 2; ++n) acc[a][b][m][n] = (f32x4){0.f, 0.f, 0.f, 0.f};
    bf16x8 At[4][2], B0[2][2], B1[2][2];
    unsigned vc[2][2], vn[2][2];
    S.a_off(cur, RR, CC, vc);
    const char* cA = S.a_base(cur); const char* cB = S.b_base(cur);
    int hdone = 0; const int hn = HOST ? (hjp->n < HOST_TAB_MAX ? hjp->n : HOST_TAB_MAX) : 0;
    const int htab = (int)(unsigned)(size_t)(lds + HOST_TAB_OFF);
#define PG8_HOST_ISSUE(d_) do { int ln_ = lane; asm volatile("" : "+v"(ln_)); const int sh_ = ((d_).z & 1u) ? 13 : 11;     \
        const unsigned long long sb_ = ((unsigned long long)(d_).y << 32) | (d_).x; \
        _Pragma("unroll") for (int q_ = 0; q_ < 2; ++q_) { const int j_ = 2 * wid + q_; \
        const float* sp_ = (const float*)((const char*)(size_t)sb_ + ((size_t)(unsigned)((8 * j_ + (ln_ >> 3)) << sh_)) + (((ln_ & 7) ^ (ln_ >> 3)) << 4)); \
        __builtin_amdgcn_global_load_lds((const unsigned*)sp_, (LAS unsigned*)(lds + HOST_OFF + j_ * 1024), 16, 0, 2); } } while (0)
    if constexpr (HOST) { u32x4 d0_; asm volatile("ds_read_b128 %0, %1" : "=v"(d0_) : "v"(htab) : "memory"); asm volatile("s_waitcnt lgkmcnt(0)" : "+v"(d0_) :: "memory"); PG8_HOST_ISSUE(d0_); }
    PG8_STAGE(PG8_SB(0, 0), cB, voffB); PG8_STAGE(PG8_SB(0, 1), cB + hstep, voffB); PG8_STAGE(PG8_SA(0, 0), cA, vc[0]); PG8_STAGE(PG8_SA(0, 1), cA, vc[1]);
    if (wr == 1) PG8_BAR;
    PG8_WAIT_V(2); PG8_BAR;
    PG8_STAGE(PG8_SB(1, 0), cB + kstep, voffB); PG8_STAGE(PG8_SA(1, 0), cA + kstepA, vc[0]); PG8_STAGE(PG8_SB(1, 1), cB + hstep + kstep, voffB);
    PG8_WAIT_V(6); PG8_BAR;
    for (;;) {
        const bool has_next = S.next(ui + 1, nxt);
        const char* nA = cA; const char* nB = cB;
#pragma unroll
        for (int h = 0; h < 2; ++h)
#pragma unroll
            for (int i = 0; i < 2; ++i) vn[h][i] = vc[h][i];
        if (has_next) { nA = S.a_base(nxt); nB = S.b_base(nxt); if constexpr (Sched::VAR_A) S.a_off(nxt, RR, CC, vn); }
        for (int t = 0; t < nt; t += 2) {
            const bool last = (t == nt - 2);
            const char* a1 = cA + (size_t)(t + 1) * kstepA;
            const char* a2 = last ? nA : cA + (size_t)(t + 2) * kstepA; const char* b2 = last ? nB : cB + (size_t)(t + 2) * kstep;
            const char* a3 = a2 + kstepA; const char* b3 = b2 + kstep;
            unsigned w0[2], w1[2];
#pragma unroll
            for (int i = 0; i < 2; ++i) { if constexpr (Sched::VAR_A) { w0[i] = last ? vn[0][i] : vc[0][i]; w1[i] = last ? vn[1][i] : vc[1][i]; } else { w0[i] = vc[0][i]; w1[i] = vc[1][i]; } }
            float hv_[8]; u32x4 hdc_, hdn_;
            PG8_LDB(B0, 0, 0); PG8_LDB(B1, 0, 1); PG8_SCHED; PG8_LDA(At, 0, 0); PG8_STAGE(PG8_SA(1, 1), a1, vc[1]);
            if constexpr (HOST) { PG8_WAIT_V(9); } else { PG8_WAIT_V(8); }
            PG8_WAIT_L(0); PG8_BAR; PG8_MMA(0, 0, At, B0); PG8_MMA(0, 1, At, B1); PG8_BAR; PG8_SCHED;
            PG8_LDA(At, 0, 1);
            int ht_ = tid; if constexpr (HOST) asm volatile("" : "+v"(ht_));
            const int hT = ht_ & 31, hkg = ht_ >> 5;
            if constexpr (HOST) { const int hrd = (int)(unsigned)(size_t)(lds + HOST_OFF) + hkg * 1024 + (hT & 3) * 4;
                _Pragma("unroll") for (int q_ = 0; q_ < 8; ++q_) asm volatile("ds_read_b32 %0, %1 offset:%c2" : "=v"(hv_[q_]) : "v"(hrd + ((((hT >> 2) ^ q_) & 7) << 4)), "i"(q_ * 128) : "memory");
                const int ic_ = hdone < hn ? hdone : hn - 1, in_ = hdone + 1 < hn ? hdone + 1 : hn - 1;
                asm volatile("ds_read_b128 %0, %1" : "=v"(hdc_) : "v"(htab + ic_ * 16) : "memory"); asm volatile("ds_read_b128 %0, %1" : "=v"(hdn_) : "v"(htab + in_ * 16) : "memory"); }
            PG8_STAGE(PG8_SB(0, 0), b2, voffB); PG8_STAGE(PG8_SB(0, 1), b2 + hstep, voffB); PG8_STAGE(PG8_SA(0, 0), a2, w0);
            PG8_WAIT_V(8); PG8_WAIT_L(0);
            if constexpr (HOST) { asm volatile("" : "+v"(hv_[0]), "+v"(hv_[1]), "+v"(hv_[2]), "+v"(hv_[3]), "+v"(hv_[4]), "+v"(hv_[5]), "+v"(hv_[6]), "+v"(hv_[7])); asm volatile("" : "+v"(hdc_), "+v"(hdn_)); }
            PG8_BAR; PG8_MMA(1, 0, At, B0); PG8_MMA(1, 1, At, B1); PG8_BAR; PG8_SCHED;
            if constexpr (HOST) { ++hdone; PG8_HOST_ISSUE(hdn_); }
            PG8_LDB(B0, 1, 0); PG8_LDB(B1, 1, 1); PG8_SCHED; PG8_LDA(At, 1, 0); PG8_STAGE(PG8_SA(0, 1), a2, w1);
            if constexpr (HOST) { PG8_WAIT_V(10); } else { PG8_WAIT_V(8); }
            PG8_WAIT_L(0); PG8_BAR; PG8_MMA(0, 0, At, B0); PG8_MMA(0, 1, At, B1); PG8_BAR; PG8_SCHED;
            PG8_LDA(At, 1, 1); PG8_STAGE(PG8_SB(1, 0), b3, voffB); PG8_STAGE(PG8_SB(1, 1), b3 + hstep, voffB); PG8_STAGE(PG8_SA(1, 0), a3, w0);
            if constexpr (HOST) { u32x2 hw_; hw_.x = pk4_fp8(hv_[0] * 16.f, hv_[1] * 16.f, hv_[2] * 16.f, hv_[3] * 16.f); hw_.y = pk4_fp8(hv_[4] * 16.f, hv_[5] * 16.f, hv_[6] * 16.f, hv_[7] * 16.f);
                const unsigned long long db_ = (((unsigned long long)hdc_.w << 32) | hdc_.z) & ~1ull; const int ks_ = (hdc_.z & 1u) ? 9 : 11;
                *(GAS u32x2*)((unsigned char*)(size_t)db_ + (size_t)(unsigned)((hT << ks_) + 8 * hkg)) = hw_;
                PG8_WAIT_V(11); } else { PG8_WAIT_V(8); }
            PG8_WAIT_L(0); PG8_BAR; PG8_MMA(1, 0, At, B0); PG8_MMA(1, 1, At, B1); PG8_BAR; PG8_SCHED;
        }
        if constexpr (ALIGN_EPI) { if (wr == 0) PG8_BAR; }
        if constexpr (FP8) asm volatile("s_nop 15\n\ts_nop 7" ::: "memory");
        E(acc, cur, wr, wc, fr, fq);
        if (!has_next) break;
#pragma unroll
        for (int a = 0; a < 2; ++a)
#pragma unroll
            for (int b = 0; b < 2; ++b)
#pragma unroll
                for (int m = 0; m < 4; ++m)
#pragma unroll
                    for (int n = 0; n < 2; ++n) acc[a][b][m][n] = (f32x4){0.f, 0.f, 0.f, 0.f};
        cur = nxt; cA = nA; cB = nB; ++ui;
#pragma unroll
        for (int h = 0; h < 2; ++h)
#pragma unroll
            for (int i = 0; i < 2; ++i) vc[h][i] = vn[h][i];
        if constexpr (ALIGN_EPI) { if (wr == 1) PG8_BAR; }
    }
    PG8_WAIT_V(0);
    if constexpr (!ALIGN_EPI) { if (wr == 0) PG8_BAR; }
    PG8_BAR;
#undef PG8_HOST_ISSUE
    return hdone < hn ? hdone : hn;
#undef PG8_SA
#undef PG8_SB
#undef PG8_STAGE
#undef PG8_LDA
#undef PG8_LDB
#undef PG8_MMA
#undef PG8_CAT8
#undef PG8_WAIT_V
#undef PG8_WAIT_L
#undef PG8_BAR
#undef PG8_SCHED
}
}

#define XB_TMO      128
#define XB_XCNT(j)  (256  + 64 * (j))
#define XB_XSUB(j)  (1280 + 64 * (j))
#define XB_XGEN(j)  (2304 + 64 * (j))
#define XB_TOP      3328
#define XB_TOPGEN   3392
#define XCD_BAR_WORDS 3456
#define XB_SPIN_CAP (1u << 18)
__device__ __forceinline__ unsigned xb_ld(unsigned* p)              { return __hip_atomic_load(p, __ATOMIC_RELAXED, __HIP_MEMORY_SCOPE_AGENT); }
__device__ __forceinline__ unsigned xb_add(unsigned* p, unsigned v) { return __hip_atomic_fetch_add(p, v, __ATOMIC_RELAXED, __HIP_MEMORY_SCOPE_AGENT); }
__device__ __forceinline__ unsigned xb_xcc_id() { return (unsigned)__builtin_amdgcn_s_getreg((3 << 11) | 20) & 0xFu; }
#define XB_SPIN(cond, bar) do { unsigned _sp = 0; while (cond) { __builtin_amdgcn_s_sleep(1); \
    if ((++_sp & 255u) == 0u) { if (xb_ld(&(bar)[XB_TMO])) break; if (_sp > XB_SPIN_CAP) { atomicAdd(&(bar)[XB_TMO], 1u); break; } } } } while (0)
struct XcdBarrier { unsigned* bar; unsigned x; volatile LAS unsigned* st; };
__device__ __forceinline__ XcdBarrier xcd_barrier_post(unsigned* bar, volatile LAS unsigned* st) {
    XcdBarrier b; b.bar = bar; b.x = xb_xcc_id(); b.st = st;
    if (threadIdx.x == 0) (void)xb_add(&bar[XB_XCNT(b.x)], 1u);
    return b;
}
__device__ __forceinline__ void xcd_barrier_complete(unsigned* bar, unsigned x, unsigned& nloc, unsigned& nx) {
    const unsigned G = gridDim.x * gridDim.y * gridDim.z;
    unsigned sum, cnt, mine, sp = 0u;
    for (;;) {
        sum = 0u; cnt = 0u; mine = 0u;
#pragma unroll
        for (unsigned j = 0; j < 16; ++j) { const unsigned c = xb_ld(&bar[XB_XCNT(j)]); sum += c; cnt += (c > 0u) ? 1u : 0u; mine = (j == x) ? c : mine; }
        if (sum == G) break;
        __builtin_amdgcn_s_sleep(1);
        if ((++sp & 255u) == 0u) { if (xb_ld(&bar[XB_TMO])) break; if (sp > XB_SPIN_CAP) { atomicAdd(&bar[XB_TMO], 1u); break; } }
    }
    nloc = mine > 0u ? mine : 1u; nx = cnt > 0u ? cnt : 1u;
}
__device__ __forceinline__ void xcd_barrier(const XcdBarrier& b) {
    asm volatile("s_waitcnt vmcnt(0)" ::: "memory");
    __syncthreads();
    if (threadIdx.x == 0) {
        unsigned* bar = b.bar;
        __builtin_amdgcn_s_waitcnt(0);
        unsigned nloc = b.st[0], nx = b.st[1];
        if (nloc == 0u) { xcd_barrier_complete(bar, b.x, nloc, nx); b.st[0] = nloc; b.st[1] = nx; }
        const unsigned old = xb_add(&bar[XB_XSUB(b.x)], 1u);
        const unsigned gen = old / nloc;
        if (old + 1u == (gen + 1u) * nloc) {
            __builtin_amdgcn_fence(__ATOMIC_RELEASE, "agent");
            asm volatile("s_waitcnt vmcnt(0)" ::: "memory");
            const unsigned og = xb_add(&bar[XB_TOP], 1u);
            const unsigned tg = og / nx;
            if (og + 1u == (tg + 1u) * nx) xb_add(&bar[XB_TOPGEN], 1u);
            else XB_SPIN(xb_ld(&bar[XB_TOPGEN]) == tg, bar);
            __builtin_amdgcn_fence(__ATOMIC_ACQUIRE, "agent");
            xb_add(&bar[XB_XGEN(b.x)], 1u);
            asm volatile("s_waitcnt vmcnt(0)" ::: "memory");
        } else {
            XB_SPIN(xb_ld(&bar[XB_XGEN(b.x)]) == gen, bar);
            __builtin_amdgcn_fence(__ATOMIC_ACQUIRE, "agent");
            asm volatile("s_waitcnt vmcnt(0)" ::: "memory");
        }
    }
    __syncthreads();
}

struct Frame {
    LAS unsigned char* lds;
    int tid, lane, wave, vcu, G;
    __device__ __forceinline__ void refresh() { tid = opaque_tid(); lane = tid & 63; wave = __builtin_amdgcn_readfirstlane(tid >> 6); }
};

struct TrItem { const float* src; unsigned char* dst; int N, K; float mul; };
__device__ __forceinline__ void tr_load(const TrItem& it, f32x4 (&v)[16], int lane) {
    const float* p = it.src + (size_t)(lane >> 4) * it.N + (lane & 15) * 4;
#pragma unroll
    for (int i = 0; i < 16; ++i) v[i] = __builtin_nontemporal_load((const f32x4*)(p + (size_t)(4 * i) * it.N));
}
__device__ __forceinline__ void tr_finish(const TrItem& it, const f32x4 (&v)[16], LAS float* scr, int lane) {
    { LAS float* w = scr + (lane >> 4) * 65 + (lane & 15) * 4;
#pragma unroll
      for (int i = 0; i < 16; ++i) { w[(4 * i) * 65 + 0] = v[i].x; w[(4 * i) * 65 + 1] = v[i].y; w[(4 * i) * 65 + 2] = v[i].z; w[(4 * i) * 65 + 3] = v[i].w; } }
    LDS_WAIT(); asm volatile("" ::: "memory");
    const int c = lane & 7;
#pragma unroll
    for (int j = 0; j < 8; ++j) { const int n = (lane >> 3) + 8 * j; const LAS float* r = scr + (8 * c) * 65 + n;
        u32x4 o; o.x = pk2(r[0 * 65], r[1 * 65]); o.y = pk2(r[2 * 65], r[3 * 65]); o.z = pk2(r[4 * 65], r[5 * 65]); o.w = pk2(r[6 * 65], r[7 * 65]);
        *(GAS u32x4*)(it.dst + ((size_t)n * it.K + 8 * c) * 2) = o; }
    LDS_WAIT(); asm volatile("" ::: "memory");
}
__device__ __forceinline__ void tr8_load(const TrItem& it, f32x4 (&v)[16], int lane) {
    const float* p = it.src + (size_t)(lane >> 3) * it.N + (lane & 7) * 4;
#pragma unroll
    for (int i = 0; i < 16; ++i) v[i] = __builtin_nontemporal_load((const f32x4*)(p + (size_t)(8 * i) * it.N));
}
__device__ __forceinline__ void tr8_finish(const TrItem& it, const f32x4 (&v)[16], LAS float* scr, int lane) {
    { LAS float* w = scr + (lane >> 3) * 33 + (lane & 7) * 4;
#pragma unroll
      for (int i = 0; i < 16; ++i) { w[(8 * i) * 33 + 0] = v[i].x; w[(8 * i) * 33 + 1] = v[i].y; w[(8 * i) * 33 + 2] = v[i].z; w[(8 * i) * 33 + 3] = v[i].w; } }
    LDS_WAIT(); asm volatile("" ::: "memory");
    const float ml = it.mul;
#pragma unroll
    for (int j = 0; j < 4; ++j) { const int n = (lane & 15) + 16 * (j >> 1), kc = (lane >> 4) + 4 * (j & 1); const LAS float* r = scr + (16 * kc) * 33 + n;
        u32x4 o;
        o.x = pk4_fp8(r[0 * 33] * ml, r[1 * 33] * ml, r[2 * 33] * ml, r[3 * 33] * ml); o.y = pk4_fp8(r[4 * 33] * ml, r[5 * 33] * ml, r[6 * 33] * ml, r[7 * 33] * ml);
        o.z = pk4_fp8(r[8 * 33] * ml, r[9 * 33] * ml, r[10 * 33] * ml, r[11 * 33] * ml); o.w = pk4_fp8(r[12 * 33] * ml, r[13 * 33] * ml, r[14 * 33] * ml, r[15 * 33] * ml);
        *(GAS u32x4*)(it.dst + (size_t)n * it.K + 16 * kc) = o; }
    LDS_WAIT(); asm volatile("" ::: "memory");
}
__device__ __forceinline__ int pair_row(int j, int p) { return (j >> 7) * 256 + p * 128 + (j & 127); }
__device__ __forceinline__ TrItem moe_item(unsigned char* ws, const float* wg, const float* wu, const float* wd, int l, int r) {
    TrItem t; const int p = r >> 13, rr = r & 8191, e = rr >> 8, q = rr & 255, le = l * NE + e;
    if (p < 2) { const int kb = q >> 4, n0 = (q & 15) * 32; unsigned char* dstm = ws + (l == 0 ? WS_WGU0 : WS_WGU1) + (size_t)e * 1024 * D;
        t.src = (p == 0 ? wg : wu) + (size_t)le * D * F + (size_t)kb * 128 * F + n0; t.N = F; t.dst = dstm + (size_t)pair_row(n0, p) * D + kb * 128; t.K = D; }
    else { const int kb = q >> 6, n0 = (q & 63) * 32; unsigned char* dstm = ws + (l == 0 ? WS_WD0 : WS_WD1) + (size_t)e * D * F;
        t.src = wd + (size_t)le * F * D + (size_t)kb * 128 * D + n0; t.N = D; t.dst = dstm + (size_t)n0 * F + kb * 128; t.K = F; }
    t.mul = 16.f; return t;
}
struct Args;
__device__ __forceinline__ void host_ptrs(unsigned char*& ws, const float*& wg, const float*& wu, const float*& wd);
__device__ __forceinline__ HostItem host_item(const HostJob& hj, int i) { unsigned char* ws; const float *wg, *wu, *wd; host_ptrs(ws, wg, wu, wd);
    const TrItem t = moe_item(ws, wg, wu, wd, hj.layer, hj.first + i * hj.stride); HostItem h; h.src = t.src; h.dst = t.dst; h.N = t.N; h.K = t.K; return h; }
__device__ __forceinline__ void host_build_table(const HostJob& hj, LAS unsigned char* lds, int tid) {
    unsigned char* ws; const float *wg, *wu, *wd; host_ptrs(ws, wg, wu, wd);
    for (int i = tid; i < hj.n && i < HOST_TAB_MAX; i += NWAVES * 64) { const TrItem t = moe_item(ws, wg, wu, wd, hj.layer, hj.first + i * hj.stride);
        unsigned long long a = (unsigned long long)(size_t)t.src, b = (unsigned long long)(size_t)t.dst | (t.N == D ? 1ull : 0ull);
        u32x4 e; e.x = (unsigned)a; e.y = (unsigned)(a >> 32); e.z = (unsigned)b; e.w = (unsigned)(b >> 32); *(LAS u32x4*)(lds + HOST_TAB_OFF + i * 16) = e; }
    __syncthreads();
}
__device__ __forceinline__ void host_leftover(const HostJob& hj, int i0, LAS float* scr, int wave, int lane) {
    unsigned char* ws; const float *wg, *wu, *wd; host_ptrs(ws, wg, wu, wd);
    for (int i = i0 + wave; i < hj.n; i += NWAVES) { const TrItem t = moe_item(ws, wg, wu, wd, hj.layer, hj.first + i * hj.stride); f32x4 v[16]; tr8_load(t, v, lane); tr8_finish(t, v, scr, lane); }
}

__device__ __forceinline__ void rms_store_bf16(const f32x4 (&v)[8], const float* gain, bf16* orow, int lane) {
    float s = 0.f;
#pragma unroll
    for (int j = 0; j < 8; ++j) s += (v[j].x * v[j].x + v[j].y * v[j].y) + (v[j].z * v[j].z + v[j].w * v[j].w);
    const float rstd = __builtin_amdgcn_rsqf(wave_sum(s) * (1.f / D) + EPS);
    GAS u32x2* o8 = (GAS u32x2*)orow + lane;
#pragma unroll
    for (int j = 0; j < 8; ++j) { const f32x4 g = *((const f32x4*)gain + lane + 64 * j); u32x2 w; w.x = pk2(v[j].x * rstd * g.x, v[j].y * rstd * g.y); w.y = pk2(v[j].z * rstd * g.z, v[j].w * rstd * g.w); o8[64 * j] = w; }
}

__device__ __forceinline__ void rms_store_fp8(const f32x4 (&v)[8], const float* gain, unsigned char* orow, int lane) {
    float s = 0.f;
#pragma unroll
    for (int j = 0; j < 8; ++j) s += (v[j].x * v[j].x + v[j].y * v[j].y) + (v[j].z * v[j].z + v[j].w * v[j].w);
    const float rstd = __builtin_amdgcn_rsqf(wave_sum(s) * (1.f / D) + EPS);
    GAS unsigned* o4 = (GAS unsigned*)orow + lane;
#pragma unroll
    for (int j = 0; j < 8; ++j) { const f32x4 g = *((const f32x4*)gain + lane + 64 * j); o4[64 * j] = pk4_fp8(v[j].x * rstd * g.x, v[j].y * rstd * g.y, v[j].z * rstd * g.z, v[j].w * rstd * g.w); }
}

template <class EpiM> __device__ __forceinline__ void meta_gemm(Frame& Fr, const bf16* A, const bf16* Bt, int N, int K, const EpiM& epi, int ct0 = 0) {
    LAS float* red = (LAS float*)Fr.lds;
    const int lane = Fr.lane, r16 = lane & 15, kq = lane >> 4, kper = K / NWAVES;
    for (int ct = ct0 + blockIdx.x; ct < N / 16; ct += gridDim.x) {
        f32x4 acc = {0.f, 0.f, 0.f, 0.f};
        const bf16* ap = A + (size_t)r16 * K + Fr.wave * kper + kq * 8;
        const bf16* bp = Bt + (size_t)(ct * 16 + r16) * K + Fr.wave * kper + kq * 8;
#pragma unroll 4
        for (int ks = 0; ks < kper / 32; ++ks) { const bf16x8 a = *(const bf16x8*)(ap + ks * 32), b = *(const bf16x8*)(bp + ks * 32); acc = __builtin_amdgcn_mfma_f32_16x16x32_bf16(a, b, acc, 0, 0, 0); }
#pragma unroll
        for (int r = 0; r < 4; ++r) red[Fr.wave * 256 + (4 * kq + r) * 16 + r16] = acc[r];
        __syncthreads();
        if (Fr.tid < 256) { float s = 0.f;
#pragma unroll
            for (int w = 0; w < NWAVES; ++w) s += red[w * 256 + Fr.tid];
            epi(Fr.tid >> 4, ct * 16 + (Fr.tid & 15), s); }
        __syncthreads();
    }
}


template <class EpiM> __device__ __forceinline__ void meta_gemm8(Frame& Fr, const unsigned char* A, const unsigned char* Bt, int N, int K, const EpiM& epi, int ct0 = 0) {
    LAS float* red = (LAS float*)Fr.lds;
    const int lane = Fr.lane, r16 = lane & 15, kq = lane >> 4, kper = K / NWAVES; const int sc8 = 0x7d7d7d7d;
    for (int ct = ct0 + blockIdx.x; ct < N / 16; ct += gridDim.x) {
        f32x4 acc = {0.f, 0.f, 0.f, 0.f};
        const unsigned char* ap = A + (size_t)r16 * K + Fr.wave * kper + kq * 32;
        const unsigned char* bp = Bt + (size_t)(ct * 16 + r16) * K + Fr.wave * kper + kq * 32;
#pragma unroll 2
        for (int ks = 0; ks < kper / 128; ++ks) { const v8i_t a = *(const v8i_t*)(ap + ks * 128), b = *(const v8i_t*)(bp + ks * 128);
            asm("v_mfma_scale_f32_16x16x128_f8f6f4 %0, %1, %2, %0, %3, %3 op_sel_hi:[0,0,0]" : "+v"(acc) : "v"(a), "v"(b), "v"(sc8)); }
        asm volatile("s_nop 15\n\ts_nop 7" : "+v"(acc) :: "memory");
#pragma unroll
        for (int r = 0; r < 4; ++r) red[Fr.wave * 256 + (4 * kq + r) * 16 + r16] = acc[r];
        __syncthreads();
        if (Fr.tid < 256) { float s = 0.f;
#pragma unroll
            for (int w = 0; w < NWAVES; ++w) s += red[w * 256 + Fr.tid];
            epi(Fr.tid >> 4, ct * 16 + (Fr.tid & 15), s); }
        __syncthreads();
    }
}

__device__ __forceinline__ int crow(int r, int hi) { return (r & 3) + 8 * (r >> 2) + 4 * hi; }
__device__ __forceinline__ void attn_issue_k(int s, int NX, int b, int h, int lane, const bf16* Kb, LAS unsigned char* kt) {
    const bool meta = (s >= NX); const int k0 = (NX - 1 - s) * 32;
#pragma unroll
    for (int i = 0; i < 8; ++i) { const int row = 4 * i + (lane >> 4), slot = lane & 15, chunk = slot ^ (row & 15);
        const size_t grow = meta ? (size_t)(M + (row < NMETA ? row : NMETA - 1)) : (size_t)b * T + k0 + row;
        __builtin_amdgcn_global_load_lds((const unsigned*)(Kb + qkv_off(grow, h * HD + chunk * 8)), (LAS unsigned*)(kt + i * 1024), 16, 0, 0); }
}
__device__ __forceinline__ void attn_issue_v(int s, int NX, int b, int h, int lane, const bf16* Vb, LAS unsigned char* vt) {
    const bool meta = (s >= NX); const int k0 = (NX - 1 - s) * 32;
#pragma unroll
    for (int i = 0; i < 8; ++i) { const int row = 4 * i + (lane >> 4), slot = lane & 15, chunk = (((slot >> 2) ^ (row & 3)) << 2) | (slot & 3);
        const size_t grow = meta ? (size_t)(M + (row < NMETA ? row : NMETA - 1)) : (size_t)b * T + k0 + row;
        __builtin_amdgcn_global_load_lds((const unsigned*)(Vb + qkv_off(grow, h * HD + chunk * 8)), (LAS unsigned*)(vt + i * 1024), 16, 0, 0); }
}
__device__ __forceinline__ void attn_task(Frame& Fr, int b, int h, int qb, const bf16* Q, const bf16* Kb, const bf16* Vb, bf16* O) {
    const int lane = Fr.lane, r32 = lane & 31, hi = lane >> 5;
    LAS unsigned char* kt = Fr.lds + Fr.wave * 16384; LAS unsigned char* vt = kt + 8192;
    const int tq0 = qb * 32; const size_t qrow0 = (size_t)b * T + tq0;
    bf16x8 qf[8];
    { const bf16* qp = Q + qkv_off(qrow0 + r32, h * HD + hi * 8);
#pragma unroll
      for (int d0 = 0; d0 < 8; ++d0) qf[d0] = *(const bf16x8*)(qp + d0 * 64); }
    f32x16 o[4];
#pragma unroll
    for (int d0 = 0; d0 < 4; ++d0)
#pragma unroll
        for (int r = 0; r < 16; ++r) o[d0][r] = 0.f;
    float wrun = 1.f;
    const int NX = qb + 1, NS = NX + 1;
    const int kta = (int)(unsigned)(size_t)kt + r32 * 256 + (((hi ^ r32) & 1) << 4), ky = (r32 & 15) >> 1;
    const int q4 = (lane & 15) >> 2, vta = (int)(unsigned)(size_t)vt + (4 * hi + q4) * 256 + ((lane >> 4) & 1) * 32 + (lane & 3) * 8;
    asm volatile("s_waitcnt vmcnt(0)" ::: "memory");
    attn_issue_k(0, NX, b, h, lane, Kb, kt); attn_issue_v(0, NX, b, h, lane, Vb, vt);
    for (int s = 0; s < NS; ++s) {
        const bool more = s + 1 < NS;
        asm volatile("s_waitcnt vmcnt(8)" ::: "memory");
        bf16x8 kf[8];
#pragma unroll
        for (int d0 = 0; d0 < 8; ++d0) asm volatile("ds_read_b128 %0, %1" : "=&v"(kf[d0]) : "v"(kta + ((d0 ^ ky) << 5)) : "memory");
        asm volatile("s_waitcnt lgkmcnt(0)" ::: "memory"); __builtin_amdgcn_sched_barrier(0);
        if (more) attn_issue_k(s + 1, NX, b, h, lane, Kb, kt);
        f32x16 p;
#pragma unroll
        for (int r = 0; r < 16; ++r) p[r] = 0.f;
#pragma unroll
        for (int d0 = 0; d0 < 8; ++d0) p = __builtin_amdgcn_mfma_f32_32x32x16_bf16(kf[d0], qf[d0], p, 0, 0, 0);
        const int lim = s == 0 ? r32 : NMETA; const bool need_mask = (s == 0 || s == NX);
#pragma unroll
        for (int r = 0; r < 16; ++r) { float e = __builtin_amdgcn_exp2f(p[r]); if (need_mask && crow(r, hi) >= lim) e = 0.f; p[r] = __builtin_amdgcn_rcpf(1.f + e); }
        float gp[4], pg[4], sfx[4];
#pragma unroll
        for (int m = 0; m < 4; ++m) gp[m] = (p[4 * m] * p[4 * m + 1]) * (p[4 * m + 2] * p[4 * m + 3]);
#pragma unroll
        for (int m = 0; m < 4; ++m) pg[m] = __shfl_xor(gp[m], 32);
        float tm = 1.f;
#pragma unroll
        for (int m = 3; m >= 0; --m) { sfx[m] = wrun * (hi == 0 ? tm * pg[m] : tm); tm = tm * (gp[m] * pg[m]); }
        wrun = wrun * tm;
        bf16x8 pa[2];
#pragma unroll
        for (int m = 0; m < 4; ++m) {
            const float w0 = p[4 * m], w1 = p[4 * m + 1], w2 = p[4 * m + 2], w3 = p[4 * m + 3];
            const float x3 = sfx[m], x2 = x3 * w3, x1 = x2 * w2, x0 = x1 * w1;
            const unsigned lo = pk2(x0 * (1.f - w0), x1 * (1.f - w1)), hh = pk2(x2 * (1.f - w2), x3 * (1.f - w3));
            const int ks = m >> 1, e0 = (m & 1) * 4;
            pa[ks][e0] = (short)(lo & 0xffff); pa[ks][e0 + 1] = (short)(lo >> 16); pa[ks][e0 + 2] = (short)(hh & 0xffff); pa[ks][e0 + 3] = (short)(hh >> 16);
        }
        if (more) asm volatile("s_waitcnt vmcnt(8)" ::: "memory"); else asm volatile("s_waitcnt vmcnt(0)" ::: "memory");
#pragma unroll
        for (int d0 = 0; d0 < 4; ++d0) {
            s16x4 lo[2], hh[2]; const int va = vta + ((d0 ^ q4) << 6);
#pragma unroll
            for (int ks = 0; ks < 2; ++ks) {
                asm volatile("ds_read_b64_tr_b16 %0, %1 offset:%c2" : "=&v"(lo[ks]) : "v"(va), "i"(ks * 4096) : "memory");
                asm volatile("ds_read_b64_tr_b16 %0, %1 offset:%c2" : "=&v"(hh[ks]) : "v"(va), "i"(ks * 4096 + 2048) : "memory"); }
            asm volatile("s_waitcnt lgkmcnt(0)" ::: "memory"); __builtin_amdgcn_sched_barrier(0);
#pragma unroll
            for (int ks = 0; ks < 2; ++ks) { const bf16x8 bv = {lo[ks][0], lo[ks][1], lo[ks][2], lo[ks][3], hh[ks][0], hh[ks][1], hh[ks][2], hh[ks][3]};
                o[d0] = __builtin_amdgcn_mfma_f32_32x32x16_bf16(pa[ks], bv, o[d0], 0, 0, 0); }
        }
        const bool dead = ATTN_EARLY_EXIT && !__any(wrun != 0.f);
        if (!more || dead) break;
        attn_issue_v(s + 1, NX, b, h, lane, Vb, vt);
    }
    asm volatile("s_waitcnt vmcnt(0)" ::: "memory");
    { LAS unsigned short* ow = (LAS unsigned short*)kt + r32;
#pragma unroll
      for (int d0 = 0; d0 < 4; ++d0)
#pragma unroll
          for (int r = 0; r < 16; ++r) ow[crow(r, hi) * HD + d0 * 32] = (unsigned short)(pk2(o[d0][r], 0.f) & 0xffffu);
      const LAS u32x4* orr = (const LAS u32x4*)kt + lane; unsigned char* og = (unsigned char*)O + qrow0 * D + h * HD + (lane & 15) * 8;
#pragma unroll
      for (int i = 0; i < 8; ++i) { const u32x4 w = orr[64 * i]; u32x2 w8; w8.x = pk4_fp8(bflo(w.x), bfhi(w.x), bflo(w.y), bfhi(w.y)); w8.y = pk4_fp8(bflo(w.z), bfhi(w.z), bflo(w.w), bfhi(w.w));
          *(u32x2*)(og + (size_t)(4 * i + (lane >> 4)) * D) = w8; } }
}

__device__ __forceinline__ void attn_piece(int j, int i, int b, int h, int lane, const bf16* Kb, const bf16* Vb, LAS unsigned char* slot) {
    asm volatile("" : "+v"(lane));
    const int row = 4 * i + (lane >> 4), sl = lane & 15;
    const size_t grow = j < 0 ? (size_t)(M + (row < NMETA ? row : NMETA - 1)) : (size_t)b * T + j * 32 + row;
    __builtin_amdgcn_global_load_lds((const unsigned*)(Kb + qkv_off(grow, h * HD + (sl ^ (row & 15)) * 8)), (LAS unsigned*)(slot + i * 1024), 16, 0, 0);
    __builtin_amdgcn_global_load_lds((const unsigned*)(Vb + qkv_off(grow, h * HD + ((((sl >> 2) ^ (row & 3)) << 2) | (sl & 3)) * 8)), (LAS unsigned*)(slot + 8192 + i * 1024), 16, 0, 0);
}
__device__ __forceinline__ void attn_wg_task(Frame& Fr, int b, int h, int g, const bf16* Q, const bf16* Kb, const bf16* Vb, bf16* O) {
    const int lane = Fr.lane, wave = Fr.wave, r32 = lane & 31, hi = lane >> 5;
    const int qb = 8 * g + wave; const size_t qrow0 = (size_t)b * T + qb * 32;
    LAS int* flags = (LAS int*)(Fr.lds + 9 * 16384);
    bf16x8 qf[8];
    { const bf16* qp = Q + qkv_off(qrow0 + r32, h * HD + hi * 8);
#pragma unroll
      for (int d0 = 0; d0 < 8; ++d0) qf[d0] = *(const bf16x8*)(qp + d0 * 64); }
    f32x16 o[4];
#pragma unroll
    for (int d0 = 0; d0 < 4; ++d0)
#pragma unroll
        for (int r = 0; r < 16; ++r) o[d0][r] = 0.f;
    float wrun = 1.f;
    const int NX = qb + 1, NS = NX + 1;
    const int kta0 = r32 * 256 + (((hi ^ r32) & 1) << 4), ky = (r32 & 15) >> 1;
    const int q4 = (lane & 15) >> 2, vta0 = 8192 + (4 * hi + q4) * 256 + ((lane >> 4) & 1) * 32 + (lane & 3) * 8;
    { LAS unsigned char* sl0 = Fr.lds + ((qb + 1) % 9) * 16384;
#pragma unroll
      for (int i = 0; i < 8; ++i) attn_piece(qb, i, b, h, lane, Kb, Vb, sl0); }
    bool alive = true;
#pragma unroll 1
    for (int sg = 0;; ++sg) {
        asm volatile("s_waitcnt vmcnt(0)" ::: "memory");
        if (lane == 0) flags[(sg & 1) * 8 + wave] = (alive && sg < NS) ? 1 : 0;
        asm volatile("s_waitcnt lgkmcnt(0)" ::: "memory"); __builtin_amdgcn_s_barrier(); asm volatile("" ::: "memory");
        int any = 0;
#pragma unroll
        for (int w = 0; w < 8; ++w) any |= flags[(sg & 1) * 8 + w];
        if (!any) break;
        { const int jn = 8 * g - sg - 1;
          if (jn >= -1) attn_piece(jn, wave, b, h, lane, Kb, Vb, Fr.lds + ((jn + 1) % 9) * 16384); }
        if (!(alive && sg < NS)) continue;
        const int s = sg, j = qb - s; const int sbase = (int)(unsigned)(size_t)(Fr.lds + ((j + 1) % 9) * 16384);
        const int kta = sbase + kta0, vta = sbase + vta0;
        bf16x8 kf[8];
#pragma unroll
        for (int d0 = 0; d0 < 8; ++d0) asm volatile("ds_read_b128 %0, %1" : "=&v"(kf[d0]) : "v"(kta + ((d0 ^ ky) << 5)) : "memory");
        asm volatile("s_waitcnt lgkmcnt(0)" ::: "memory"); __builtin_amdgcn_sched_barrier(0);
        f32x16 p;
#pragma unroll
        for (int r = 0; r < 16; ++r) p[r] = 0.f;
#pragma unroll
        for (int d0 = 0; d0 < 8; ++d0) p = __builtin_amdgcn_mfma_f32_32x32x16_bf16(kf[d0], qf[d0], p, 0, 0, 0);
        const int lim = s == 0 ? r32 : NMETA; const bool need_mask = (s == 0 || s == NX);
#pragma unroll
        for (int r = 0; r < 16; ++r) { float e = __builtin_amdgcn_exp2f(p[r]); if (need_mask && crow(r, hi) >= lim) e = 0.f; p[r] = __builtin_amdgcn_rcpf(1.f + e); }
        float gp[4], pg[4], sfx[4];
#pragma unroll
        for (int m = 0; m < 4; ++m) gp[m] = (p[4 * m] * p[4 * m + 1]) * (p[4 * m + 2] * p[4 * m + 3]);
#pragma unroll
        for (int m = 0; m < 4; ++m) pg[m] = __shfl_xor(gp[m], 32);
        float tm = 1.f;
#pragma unroll
        for (int m = 3; m >= 0; --m) { sfx[m] = wrun * (hi == 0 ? tm * pg[m] : tm); tm = tm * (gp[m] * pg[m]); }
        wrun = wrun * tm;
        bf16x8 pa[2];
#pragma unroll
        for (int m = 0; m < 4; ++m) {
            const float w0 = p[4 * m], w1 = p[4 * m + 1], w2 = p[4 * m + 2], w3 = p[4 * m + 3];
            const float x3 = sfx[m], x2 = x3 * w3, x1 = x2 * w2, x0 = x1 * w1;
            const unsigned lo = pk2(x0 * (1.f - w0), x1 * (1.f - w1)), hh = pk2(x2 * (1.f - w2), x3 * (1.f - w3));
            const int ks = m >> 1, e0 = (m & 1) * 4;
            pa[ks][e0] = (short)(lo & 0xffff); pa[ks][e0 + 1] = (short)(lo >> 16); pa[ks][e0 + 2] = (short)(hh & 0xffff); pa[ks][e0 + 3] = (short)(hh >> 16);
        }
#pragma unroll
        for (int d0 = 0; d0 < 4; ++d0) {
            s16x4 lo[2], hh[2]; const int va = vta + ((d0 ^ q4) << 6);
#pragma unroll
            for (int ks = 0; ks < 2; ++ks) {
                asm volatile("ds_read_b64_tr_b16 %0, %1 offset:%c2" : "=&v"(lo[ks]) : "v"(va), "i"(ks * 4096) : "memory");
                asm volatile("ds_read_b64_tr_b16 %0, %1 offset:%c2" : "=&v"(hh[ks]) : "v"(va), "i"(ks * 4096 + 2048) : "memory"); }
            asm volatile("s_waitcnt lgkmcnt(0)" ::: "memory"); __builtin_amdgcn_sched_barrier(0);
#pragma unroll
            for (int ks = 0; ks < 2; ++ks) { const bf16x8 bv = {lo[ks][0], lo[ks][1], lo[ks][2], lo[ks][3], hh[ks][0], hh[ks][1], hh[ks][2], hh[ks][3]};
                o[d0] = __builtin_amdgcn_mfma_f32_32x32x16_bf16(pa[ks], bv, o[d0], 0, 0, 0); }
        }
        if (ATTN_EARLY_EXIT && !__any(wrun != 0.f)) alive = false;
    }
    { LAS unsigned char* kt = Fr.lds + wave * 16384; LAS unsigned short* ow = (LAS unsigned short*)kt + r32;
#pragma unroll
      for (int d0 = 0; d0 < 4; ++d0)
#pragma unroll
          for (int r = 0; r < 16; ++r) ow[crow(r, hi) * HD + d0 * 32] = (unsigned short)(pk2(o[d0][r], 0.f) & 0xffffu);
      const LAS u32x4* orr = (const LAS u32x4*)kt + lane; unsigned char* og = (unsigned char*)O + qrow0 * D + h * HD + (lane & 15) * 8;
#pragma unroll
      for (int i = 0; i < 8; ++i) { const u32x4 w = orr[64 * i]; u32x2 w8; w8.x = pk4_fp8(bflo(w.x), bfhi(w.x), bflo(w.y), bfhi(w.y)); w8.y = pk4_fp8(bflo(w.z), bfhi(w.z), bflo(w.w), bfhi(w.w));
          *(u32x2*)(og + (size_t)(4 * i + (lane >> 4)) * D) = w8; } }
    asm volatile("s_waitcnt lgkmcnt(0)" ::: "memory"); __builtin_amdgcn_s_barrier(); asm volatile("" ::: "memory");
}

__device__ __forceinline__ int build_tab(Frame& Fr, LAS int* gtab, gu32* ctl, int l, int nct) {
    if (Fr.tid < 32) gtab[Fr.tid] = (int)__hip_atomic_load(ctl + CW_CNT + (l * 32 + Fr.tid) * 64, RLX_AGENT);
    __syncthreads();
    if (Fr.tid == 0) { int c = 0; for (int e = 0; e < NE; ++e) { gtab[32 + e] = c; c += (gtab[e] + 255) >> 8; } gtab[64] = c; }
    __syncthreads();
    return gtab[64] * nct;
}
__device__ __forceinline__ void rt_issue_h(const bf16* Hs, int row0, int wave, int lane, LAS unsigned char* ht) {
    asm volatile("" : "+v"(lane));
#pragma unroll
    for (int i = 0; i < 8; ++i) { const int row = 2 * i + (lane >> 5), sl = lane & 31, c = sl ^ (row & 15);
        __builtin_amdgcn_global_load_lds((const unsigned*)(Hs + (size_t)(row0 + row) * D + wave * 256 + c * 8), (LAS unsigned*)(ht + i * 1024), 16, 0, 0); }
}
__device__ __forceinline__ void router_phase(Frame& Fr, int l, int cl, int ngroups, const float* gain, const bf16* Hs, bf16* XN, const bf16* RW, const float* rgb, const float* reb, gu32* ctl, int* LTOK, float* LGATE, float* LRSTD) {
    const int lane = Fr.lane, wave = Fr.wave, r16 = lane & 15, kq = lane >> 4, tid = Fr.tid;
    LAS float* gl = (LAS float*)Fr.lds;
    LAS float* part = (LAS float*)(Fr.lds + 8192);
    LAS float* sq = (LAS float*)(Fr.lds + 8192 + 49152);
    LAS float* fin = (LAS float*)(Fr.lds + 8192 + 49152 + 1024);
    LAS float* ssf = (LAS float*)(Fr.lds + 8192 + 49152 + 1024 + 15360);
    LAS unsigned* hist = (LAS unsigned*)(Fr.lds + 8192 + 49152 + 1024 + 15360 + 512);
    LAS unsigned char* ht = Fr.lds + 77824 + wave * 8192;
    for (int i = tid; i < D / 4; i += NWAVES * 64) ((LAS f32x4*)gl)[i] = ((const f32x4*)gain)[i];
    if (tid < 32) hist[tid] = 0u;
    int round = 0, grp = Fr.vcu;
    if (grp < ngroups) rt_issue_h(Hs, grp * 16, wave, lane, ht);
#define RT_KOF(ks) (wave * 256 + ((ks) >> 1) * 64 + kq * 16 + ((ks) & 1) * 8)
    const bf16* whi = RW + (size_t)l * 2 * 48 * D + (size_t)r16 * D;
    bf16x8 wreg[8][3];
#pragma unroll
    for (int ks = 0; ks < 8; ++ks)
#pragma unroll
        for (int c = 0; c < 3; ++c) wreg[ks][c] = *(const bf16x8*)(whi + (size_t)c * 16 * D + RT_KOF(ks));
    __syncthreads();
    if (grp >= ngroups) return;
    for (;;) {
        const int row0 = grp * 16;
        const int nxt = grp + Fr.G; const bool has = nxt < ngroups;
        asm volatile("s_waitcnt vmcnt(0)" ::: "memory");
        u32x4 hv[8];
#pragma unroll
        for (int ks = 0; ks < 8; ++ks) hv[ks] = *(const LAS u32x4*)(ht + r16 * 512 + (((((ks >> 1) * 8 + kq * 2 + (ks & 1)) ^ r16) & 31) << 4));
        asm volatile("s_waitcnt lgkmcnt(0)" ::: "memory");
        if (has) rt_issue_h(Hs, nxt * 16, wave, lane, ht);
        unsigned char* xp = (unsigned char*)XN + (size_t)(row0 + r16) * D + wave * 256 + kq * 16;
        f32x4 acc[3]; float ssq = 0.f; u32x2 x8e;
#pragma unroll
        for (int c = 0; c < 3; ++c) acc[c] = (f32x4){0.f, 0.f, 0.f, 0.f};
#pragma unroll
        for (int ks = 0; ks < 8; ++ks) {
            const u32x4 hq = hv[ks]; const f32x4 h0 = (f32x4){bflo(hq.x), bfhi(hq.x), bflo(hq.y), bfhi(hq.y)}, h1 = (f32x4){bflo(hq.z), bfhi(hq.z), bflo(hq.w), bfhi(hq.w)}, g0 = *(const LAS f32x4*)(gl + RT_KOF(ks)), g1 = *(const LAS f32x4*)(gl + RT_KOF(ks) + 4);
            ssq += ((h0.x * h0.x + h0.y * h0.y) + (h0.z * h0.z + h0.w * h0.w)) + ((h1.x * h1.x + h1.y * h1.y) + (h1.z * h1.z + h1.w * h1.w));
            const float xv[8] = {h0.x * g0.x, h0.y * g0.y, h0.z * g0.z, h0.w * g0.w, h1.x * g1.x, h1.y * g1.y, h1.z * g1.z, h1.w * g1.w};
            { u32x2 x8; x8.x = pk4_fp8(xv[0], xv[1], xv[2], xv[3]); x8.y = pk4_fp8(xv[4], xv[5], xv[6], xv[7]);
              if ((ks & 1) == 0) x8e = x8; else { u32x4 x16; x16.x = x8e.x; x16.y = x8e.y; x16.z = x8.x; x16.w = x8.y; *(u32x4*)(xp + (ks >> 1) * 64) = x16; } }
            const bf16x8 ah = __builtin_bit_cast(bf16x8, hq);
#pragma unroll
            for (int c = 0; c < 3; ++c) acc[c] = __builtin_amdgcn_mfma_f32_16x16x32_bf16(ah, wreg[ks][c], acc[c], 0, 0, 0);
        }
#undef RT_KOF
        ssq += __shfl_xor(ssq, 16); ssq += __shfl_xor(ssq, 32);
        LAS float* pb = part + (round & 1) * (8 * 16 * 48) + wave * (16 * 48);
#pragma unroll
        for (int c = 0; c < 3; ++c)
#pragma unroll
            for (int r = 0; r < 4; ++r) pb[(4 * kq + r) * 48 + c * 16 + r16] = acc[c][r];
        if (kq == 0) sq[(round & 1) * 128 + wave * 16 + r16] = ssq;
        LDS_WAIT(); __builtin_amdgcn_s_barrier(); asm volatile("" ::: "memory");
        for (int t = tid; t < 784; t += NWAVES * 64) {
            if (t < 768) { const LAS float* P = part + (round & 1) * (8 * 16 * 48) + t; float a = 0.f;
#pragma unroll
                for (int w = 0; w < 8; ++w) a += P[w * (16 * 48)];
                fin[round * 768 + t] = a; }
            else { const LAS float* Q = sq + (round & 1) * 128 + (t - 768); float a = 0.f;
#pragma unroll
                for (int w = 0; w < 8; ++w) a += Q[w * 16];
                ssf[round * 16 + (t - 768)] = a; }
        }
        if (!has) break;
        grp = nxt; ++round;
    }
    VM_WAIT(); __syncthreads();
    const int nrows = (round + 1) * 16;
    int tok = 0, e0 = 0, e1 = 0; unsigned k0 = 0, k1 = 0; float g0 = 0.f, g1 = 0.f, rstd = 0.f;
    if (tid < nrows) {
        const int ri = tid >> 4, rr = tid & 15; tok = (Fr.vcu + ri * Fr.G) * 16 + rr;
        const LAS float* L = fin + ri * 768 + rr * 48;
        rstd = __builtin_amdgcn_rsqf(ssf[ri * 16 + rr] * (1.f / D) + EPS);
        const float* bg = rgb + l * NG; const float* be = reb + l * NE;
        float gl4[4];
#pragma unroll
        for (int j = 0; j < 4; ++j) gl4[j] = L[j] * rstd + bg[j];
        float gm = gl4[0]; int gs = 0; if (gl4[1] > gm) { gm = gl4[1]; gs = 1; } if (gl4[2] > gm) { gm = gl4[2]; gs = 2; } if (gl4[3] > gm) { gm = gl4[3]; gs = 3; }
        const float ptop = 1.f / (__expf(gl4[0] - gm) + __expf(gl4[1] - gm) + __expf(gl4[2] - gm) + __expf(gl4[3] - gm));
        float v0 = -INFINITY, v1 = -INFINITY; int i0 = 0, i1 = 0;
#pragma unroll
        for (int i = 0; i < EPG; ++i) { const float v = L[16 + gs * EPG + i] * rstd + be[gs * EPG + i];
            if (v > v0) { v1 = v0; i1 = i0; v0 = v; i0 = i; } else if (v > v1) { v1 = v; i1 = i; } }
        const float ex = __expf(v1 - v0), inv = 1.f / (1.f + ex); g0 = inv * ptop; g1 = ex * inv * ptop;
        e0 = gs * EPG + i0; e1 = gs * EPG + i1;
        k0 = __hip_atomic_fetch_add(hist + e0, 1u, __ATOMIC_RELAXED, __HIP_MEMORY_SCOPE_WORKGROUP);
        k1 = __hip_atomic_fetch_add(hist + e1, 1u, __ATOMIC_RELAXED, __HIP_MEMORY_SCOPE_WORKGROUP);
    }
    __syncthreads();
    if (tid < 32) { const unsigned c = hist[tid]; hist[32 + tid] = c ? __hip_atomic_fetch_add(ctl + CW_CNT + (cl * 32 + tid) * 64, c, RLX_AGENT) : 0u; }
    __syncthreads();
    if (tid < nrows) {
        const unsigned p0 = hist[32 + e0] + k0, p1 = hist[32 + e1] + k1;
        LTOK[(size_t)e0 * CAP + p0] = tok; LGATE[(size_t)e0 * CAP + p0] = g0; LRSTD[(size_t)e0 * CAP + p0] = rstd;
        LTOK[(size_t)e1 * CAP + p1] = tok | (int)0x80000000; LGATE[(size_t)e1 * CAP + p1] = g1; LRSTD[(size_t)e1 * CAP + p1] = rstd;
    }
    __syncthreads();
}

struct Args { const float* in[17]; float* out; unsigned char* ws; int ph_lo, ph_hi; };
static_assert(sizeof(Args) == 17 * 8 + 8 + 8 + 8, "Args has no padding");
__device__ __forceinline__ void host_ptrs(unsigned char*& ws, const float*& wg, const float*& wu, const float*& wd) {
    const __attribute__((address_space(4))) char* ka = (const __attribute__((address_space(4))) char*)__builtin_amdgcn_kernarg_segment_ptr(); asm volatile("" : "+s"(ka));
    const __attribute__((address_space(4))) Args* a = (const __attribute__((address_space(4))) Args*)ka;
    ws = a->ws; wg = a->in[13]; wu = a->in[14]; wd = a->in[15];
}

struct L1Split { int n1, c3, c8; };
__device__ __forceinline__ int dense_units(int nwg, int G, int c) { return c < nwg ? (nwg - 1 - c) / G + 1 : 0; }
__device__ __forceinline__ L1Split l1_split(int vcu, int G, int c) {
    L1Split s; s.n1 = (3 * 8192 - vcu + G - 1) / G;
    const int cap3 = dense_units((M / 256) * (D / 256), G, c) * 16, cap8 = dense_units((M / 256) * (3 * D / 256), G, c) * 8;
    s.c3 = s.n1 < cap3 ? s.n1 : cap3; const int r = s.n1 - s.c3; s.c8 = r < cap8 ? r : cap8; return s;
}

__global__ void __launch_bounds__(NWAVES * 64, 2) fwd_kernel(Args args) {
    extern __shared__ __attribute__((aligned(16))) unsigned char lds_raw[];
    Frame Fr;
    Fr.lds = (LAS unsigned char*)lds_raw;
    Fr.tid = threadIdx.x; Fr.lane = Fr.tid & 63; Fr.wave = __builtin_amdgcn_readfirstlane(Fr.tid >> 6);
    Fr.G = gridDim.x; { const int bx = blockIdx.x; Fr.vcu = (Fr.G % 8 == 0) ? (bx % 8) * (Fr.G / 8) + bx / 8 : bx; }
    volatile LAS unsigned* MISC = (volatile LAS unsigned*)(Fr.lds + MISC_OFF);
    LAS int* gtab = (LAS int*)(Fr.lds + GTAB_OFF);
    unsigned char* ws = args.ws;
    gu32* ctl = (gu32*)(ws + WS_CTL);
    const float* x = args.in[0]; const float* meta_tok = args.in[1]; const float* norm_mix_g = args.in[2]; const float* norm_ffn_g = args.in[3];
    const float* conv_w_in = args.in[4]; const float* conv_w = args.in[5]; const float* conv_w_out = args.in[6]; const float* attn_w_qkv = args.in[7]; const float* attn_w_out = args.in[8];
    const float* rgw = args.in[9]; const float* rgb = args.in[10]; const float* rew = args.in[11]; const float* reb = args.in[12];
    const float* moe_w_gate = args.in[13]; const float* moe_w_up = args.in[14]; const float* moe_w_down = args.in[15]; const float* final_g = args.in[16];
    float* out = args.out;
    bf16* WIN0 = (bf16*)(ws + WS_WIN0); bf16* WOUT0 = (bf16*)(ws + WS_WOUT0); bf16* WQKV = (bf16*)(ws + WS_WQKV); bf16* WOUT1 = (bf16*)(ws + WS_WOUT1);
    bf16* RW = (bf16*)(ws + WS_RW); bf16* XN = (bf16*)(ws + WS_XN);
    bf16* R0 = (bf16*)(ws + WS_R0); bf16* R1 = (bf16*)(ws + WS_R1); bf16* R2 = (bf16*)(ws + WS_R2);
    bf16* Hs = (bf16*)(ws + WS_H); bf16* HG = (bf16*)(ws + WS_HG); int* LTOK = (int*)(ws + WS_LTOK); float* LGATE = (float*)(ws + WS_LGATE); float* LRSTD = (float*)(ws + WS_LRSTD); float* MSCR = (float*)(ws + WS_MSCR);

    for (int u = Fr.tid; u < (LDS_BYTES - LDSCTL_OFF) / 4; u += NWAVES * 64) ((LAS unsigned*)(Fr.lds + LDSCTL_OFF))[u] = 0u;
    __syncthreads();
    XcdBarrier bar; bar.bar = (unsigned*)(ctl + CW_BAR); bar.x = 0; bar.st = nullptr;
    if (MK_N_LAUNCHES == 1) bar = xcd_barrier_post((unsigned*)(ctl + CW_BAR), MISC + 8);
#define GRID_BAR() do { if (MK_N_LAUNCHES == 1) xcd_barrier(bar); } while (0)
    const int lo = args.ph_lo, hi = args.ph_hi;
#define IN(k) (lo <= (k) && (k) < hi)
#define REP(k) for (int rep_ = 0; rep_ < 1 + ((PROBE_DUP >> (k)) & 1); ++rep_)
#define BOTH(k) (IN(k) && IN((k) + 1))
    const int NGW = Fr.G * NWAVES;
#define gw (Fr.vcu * NWAVES + Fr.wave)
#define lane (Fr.lane)

    if (IN(0)) {
        Fr.refresh();
        REP(0) {
        LAS float* scr = (LAS float*)(Fr.lds + Fr.wave * 16896);
        constexpr int I_IN = 32 * 96, I_OUT = 32 * 32;
        constexpr int NITEMS = 2 * I_IN + 2 * I_OUT;
        auto item_of = [=](int r) -> TrItem {
            TrItem t; t.mul = 0.f;
            if (r < I_IN) { const int kb = r / 96, n0 = (r % 96) * 64; int drow;
                if (n0 < D) drow = n0; else if (n0 < 2 * D) drow = D + pair_row(n0 - D, 0); else drow = D + pair_row(n0 - 2 * D, 1);
                t.src = conv_w_in + (size_t)kb * 64 * (3 * D) + n0; t.N = 3 * D; t.dst = (unsigned char*)(WIN0 + (size_t)drow * D + kb * 64); t.K = D; return t; } r -= I_IN;
            if (r < I_IN) { const int kb = r / 192, n0 = (r % 192) * 32; t.src = attn_w_qkv + (size_t)kb * 128 * (3 * D) + n0; t.N = 3 * D; t.dst = (unsigned char*)WQKV + (size_t)n0 * D + kb * 128; t.K = D; t.mul = 16.f; return t; } r -= I_IN;
            if (r < I_OUT) { const int kb = r / 32, n0 = (r % 32) * 64; t.src = conv_w_out + (size_t)kb * 64 * D + n0; t.N = D; t.dst = (unsigned char*)(WOUT0 + (size_t)n0 * D + kb * 64); t.K = D; return t; } r -= I_OUT;
            { const int kb = r / 64, n0 = (r % 64) * 32; t.src = attn_w_out + (size_t)kb * 128 * D + n0; t.N = D; t.dst = (unsigned char*)WOUT1 + (size_t)n0 * D + kb * 128; t.K = D; t.mul = 16.f; return t; }
        };
        if (gw < NITEMS) {
            f32x4 va[16], vb[16]; TrItem ia = item_of(gw), ib = ia;
#define TR_LOAD(it_, v_) do { if ((it_).mul == 0.f) tr_load(it_, v_, lane); else tr8_load(it_, v_, lane); } while (0)
#define TR_FINISH(it_, v_) do { if ((it_).mul == 0.f) tr_finish(it_, v_, scr, lane); else tr8_finish(it_, v_, scr, lane); } while (0)
            TR_LOAD(ia, va);
            for (int it = gw; it < NITEMS; it += 2 * NGW) {
                const bool hb = it + NGW < NITEMS; if (hb) { ib = item_of(it + NGW); TR_LOAD(ib, vb); }
                TR_FINISH(ia, va);
                if (!hb) break;
                const bool ha = it + 2 * NGW < NITEMS; if (ha) { ia = item_of(it + 2 * NGW); TR_LOAD(ia, va); }
                TR_FINISH(ib, vb);
                if (!ha) break;
            }
#undef TR_LOAD
#undef TR_FINISH
        }
        for (int idx = blockIdx.x * (NWAVES * 64) + Fr.tid; idx < 2 * 48 * D; idx += Fr.G * NWAVES * 64) {
            const int l = idx / (48 * D), j = (idx / D) % 48, k = idx % D;
            float w = 0.f; if (j < NG) w = rgw[((size_t)l * D + k) * NG + j]; else if (j >= 16) w = rew[((size_t)l * D + k) * NE + (j - 16)];
            w *= norm_ffn_g[(size_t)l * D + k];
            const unsigned hb = pk2(w, 0.f) & 0xffffu; const float lw = w - bf2f((unsigned short)hb);
            RW[(size_t)l * 2 * 48 * D + (size_t)j * D + k] = (bf16)hb; RW[(size_t)l * 2 * 48 * D + (size_t)(48 + j) * D + k] = (bf16)(pk2(lw, 0.f) & 0xffffu);
        }
        {
#define P0_LOAD(m_, v_) do { const float* src_ = (m_) < M ? x + (size_t)(m_) * D : meta_tok + (size_t)((m_) - M) * D; _Pragma("unroll") for (int j = 0; j < 8; ++j) v_[j] = *((const f32x4*)src_ + lane + 64 * j); } while (0)
            f32x4 va[8], vb[8];
            if (gw < MT) P0_LOAD(gw, va);
            for (int m = gw; m < MT; m += 2 * NGW) {
                const int m1 = m + NGW, m2 = m + 2 * NGW;
                if (m1 < MT) P0_LOAD(m1, vb);
                rms_store_bf16(va, norm_mix_g, XN + (size_t)m * D, lane);
                if (m1 >= MT) break;
                if (m2 < MT) P0_LOAD(m2, va);
                rms_store_bf16(vb, norm_mix_g, XN + (size_t)m1 * D, lane);
            }
#undef P0_LOAD
        }
        }
        if (BOTH(0)) GRID_BAR();
    }
    if (IN(1)) {
        Fr.refresh();
        REP(1) {
        { float* ms = MSCR; auto epi = [=](int i, int n, float v) { ms[i * (3 * D) + n] = v; }; meta_gemm(Fr, XN + (size_t)M * D, WIN0, 3 * D, D, epi); }
        pg8::DenseOrder S; S.init(XN, WIN0 + (size_t)D * D, M, 2 * D, D, Fr.G, (int)blockIdx.x);
        pg8::EpiCH E{R1};
        HostJob hj{0, Fr.vcu, Fr.G, 0, (3 * 8192 - Fr.vcu + Fr.G - 1) / Fr.G};
        host_build_table(hj, Fr.lds, Fr.tid);
        const int hd = pg8::gemm_phase<pg8::EpiCH, pg8::DenseOrder, true, false, true>(Fr.lds, S, E, &hj);
        (void)hd;
        }
        if (BOTH(1)) GRID_BAR();
    }
    if (IN(2)) {
        Fr.refresh();
        REP(2) {
        if (blockIdx.x < NMETA) { const int i = blockIdx.x;
            for (int c = Fr.tid; c < D; c += NWAVES * 64) {
                float y = 0.f;
#pragma unroll
                for (int kk = 0; kk < 3; ++kk) { const int ii = i - 2 + kk; if (ii >= 0) { const float cv = MSCR[ii * (3 * D) + D + pair_row(c, 0)], hv = MSCR[ii * (3 * D) + D + pair_row(c, 1)]; y += conv_w[kk * D + c] * bf2f((unsigned short)(pk2(cv * hv, 0.f) & 0xffffu)); } }
                const float bgv = bf2f((unsigned short)(pk2(MSCR[i * (3 * D) + c], 0.f) & 0xffffu));
                R2[(size_t)(M + i) * D + c] = (bf16)(pk2(bgv * y, 0.f) & 0xffffu); } }
        pg8::DenseOrder S; S.init(XN, WIN0, M, D, D, Fr.G, (int)blockIdx.x);
        pg8::EpiGateConv E{R1, R2, conv_w, MSCR};
        int hstart; { pg8::DenseOrder S1; S1.init(XN, WIN0 + (size_t)D * D, M, 2 * D, D, Fr.G, (int)blockIdx.x); pg8::Unit uu; int nu1 = 0; while (S1.next(nu1, uu)) ++nu1; hstart = nu1 * (D / 128); }
        HostJob hj{0, Fr.vcu, Fr.G, 0, (3 * 8192 - Fr.vcu + Fr.G - 1) / Fr.G};
        if (hstart > hj.n) hstart = hj.n;
        hj.i0 = hstart;
        int hd = 0;
        if (hj.i0 < hj.n) { HostJob h2 = hj; h2.n = hj.n - hj.i0; h2.first = hj.first + hj.i0 * hj.stride; h2.i0 = 0; host_build_table(h2, Fr.lds, Fr.tid); hd = pg8::gemm_phase<pg8::EpiGateConv, pg8::DenseOrder, true, false, true>(Fr.lds, S, E, &h2); }
        else pg8::gemm_phase<pg8::EpiGateConv, pg8::DenseOrder, true>(Fr.lds, S, E);
        Fr.refresh();
        host_leftover(hj, hj.i0 + hd, (LAS float*)(Fr.lds + Fr.wave * 16896), Fr.wave, lane);
        }
        if (BOTH(2)) GRID_BAR();
    }
    if (IN(3)) {
        Fr.refresh();
        REP(3) {
        { bf16* hs = Hs; const float* mt = meta_tok; auto epi = [=](int i, int n, float v) { hs[(size_t)(M + i) * D + n] = (bf16)(pk2(mt[i * D + n] + v, 0.f) & 0xffffu); }; meta_gemm(Fr, R2 + (size_t)M * D, WOUT0, D, D, epi); }
        pg8::DenseOrderT<true> S; S.init(R2, WOUT0, M, D, D, Fr.G, (int)blockIdx.x);
        pg8::EpiResid<true> E{x, Hs};
        const L1Split sp = l1_split(Fr.vcu, Fr.G, (int)blockIdx.x);
        HostJob hj{1, Fr.vcu, Fr.G, 0, sp.c3 > 0 ? sp.c3 : 1};
        host_build_table(hj, Fr.lds, Fr.tid);
        pg8::gemm_phase<pg8::EpiResid<true>, pg8::DenseOrderT<true>, true, false, true>(Fr.lds, S, E, &hj);
        }
        if (BOTH(3)) GRID_BAR();
    }
    if (IN(4)) {
        Fr.refresh();
        REP(4) {
        router_phase(Fr, 0, 0, MT / 16, norm_ffn_g, Hs, XN, RW, rgb, reb, ctl, LTOK, LGATE, LRSTD);
        }
        if (BOTH(4)) GRID_BAR();
    }
    if (IN(5)) {
        Fr.refresh();
        REP(5) {
        const int nu = build_tab(Fr, gtab, ctl, 0, 4);
        pg8::GroupedOrder<true> S; S.A = XN; S.Bt = ws + WS_WGU0; S.ltok = LTOK; S.tab = gtab; S.K = D; S.rowb = D; S.wscale = 0; S.NCT = 4; S.nunits = nu; S.G = Fr.G; S.c = (int)blockIdx.x; S.bstride = (size_t)1024 * D;
        S.tokl = (const LAS int*)(Fr.lds + 131072); pg8::prefill_tokens(S, (LAS int*)(Fr.lds + 131072), (LAS float*)(Fr.lds + 131072 + 6144), LRSTD, 6, false);
        pg8::EpiGateUp E{(unsigned char*)HG, (const LAS float*)(Fr.lds + 131072 + 6144)};
        pg8::gemm_phase<pg8::EpiGateUp, pg8::GroupedOrder<true>, true, true>(Fr.lds, S, E);
        }
        if (BOTH(5)) GRID_BAR();
    }
    if (IN(6)) {
        Fr.refresh();
        REP(6) {
        const int nu = build_tab(Fr, gtab, ctl, 0, 8);
        pg8::GroupedOrder<false> S; S.A = HG; S.Bt = ws + WS_WD0; S.ltok = LTOK; S.tab = gtab; S.K = F; S.rowb = F; S.wscale = 0; S.NCT = 8; S.nunits = nu; S.G = Fr.G; S.c = (int)blockIdx.x; S.bstride = (size_t)D * F; S.tokl = nullptr;
        pg8::prefill_tokens(S, (LAS int*)(Fr.lds + 131072), (LAS float*)(Fr.lds + 131072 + 7168), LGATE, 7, true);
        pg8::EpiDown E{R0, R1, (const LAS int*)(Fr.lds + 131072), (const LAS float*)(Fr.lds + 131072 + 7168)};
        pg8::gemm_phase<pg8::EpiDown, pg8::GroupedOrder<false>, true, true>(Fr.lds, S, E);
        }
        if (BOTH(6)) GRID_BAR();
    }
    if (IN(7)) {
        Fr.refresh();
        {
#define P7_LOAD(m_, h_, a_, c_) do { const u32x2* hr_ = (const u32x2*)(Hs + (size_t)(m_) * D) + lane; const u32x2* y0_ = (const u32x2*)(R0 + (size_t)(m_) * D) + lane; const u32x2* y1_ = (const u32x2*)(R1 + (size_t)(m_) * D) + lane; \
            _Pragma("unroll") for (int j = 0; j < 8; ++j) { h_[j] = hr_[64 * j]; a_[j] = y0_[64 * j]; c_[j] = y1_[64 * j]; } } while (0)
#define P7_DO(m_, h_, a_, c_) do { f32x4 v[8]; u32x2* hr_ = (u32x2*)(Hs + (size_t)(m_) * D) + lane; \
            _Pragma("unroll") for (int j = 0; j < 8; ++j) { const u32x2 h = h_[j], a = a_[j], c = c_[j]; \
                v[j].x = (bflo(h.x) + bflo(a.x)) + bflo(c.x); v[j].y = (bfhi(h.x) + bfhi(a.x)) + bfhi(c.x); v[j].z = (bflo(h.y) + bflo(a.y)) + bflo(c.y); v[j].w = (bfhi(h.y) + bfhi(a.y)) + bfhi(c.y); \
                u32x2 w; w.x = pk2(v[j].x, v[j].y); w.y = pk2(v[j].z, v[j].w); hr_[64 * j] = w; } \
            rms_store_fp8(v, norm_mix_g + D, (unsigned char*)XN + (size_t)(m_) * D, lane); } while (0)
            u32x2 ha[8], aa[8], ca[8], hb[8], ab[8], cb[8];
            if (gw < MT) P7_LOAD(gw, ha, aa, ca);
            for (int m = gw; m < MT; m += 2 * NGW) {
                const int m1 = m + NGW, m2 = m + 2 * NGW;
                if (m1 < MT) P7_LOAD(m1, hb, ab, cb);
                P7_DO(m, ha, aa, ca);
                if (m1 >= MT) break;
                if (m2 < MT) P7_LOAD(m2, ha, aa, ca);
                P7_DO(m1, hb, ab, cb);
            }
#undef P7_LOAD
#undef P7_DO
        }
        if (BOTH(7)) GRID_BAR();
    }
    if (IN(8)) {
        Fr.refresh();
        REP(8) {
        { bf16* kk = R1; bf16* vv = R2; auto epi = [=](int i, int n, float v) { if (n >= 2 * D) vv[qkv_off((size_t)(M + i), n - 2 * D)] = (bf16)(pk2(v, 0.f) & 0xffffu); else if (n >= D) kk[qkv_off((size_t)(M + i), n - D)] = (bf16)(pk2(v, 0.f) & 0xffffu); };
          meta_gemm8(Fr, (const unsigned char*)XN + (size_t)M * D, (const unsigned char*)WQKV, 3 * D, D, epi, D / 16); }
        pg8::DenseOrder S; S.init(XN, WQKV, M, 3 * D, D, Fr.G, (int)blockIdx.x, 1);
        pg8::EpiQKV E{R0, (size_t)(WS_R1 - WS_R0) / 2, QSCALE};
        const L1Split sp = l1_split(Fr.vcu, Fr.G, (int)blockIdx.x);
        HostJob hj{1, Fr.vcu + (sp.c8 > 0 ? sp.c3 : 0) * Fr.G, Fr.G, 0, sp.c8 > 0 ? sp.c8 : 1};
        host_build_table(hj, Fr.lds, Fr.tid);
        pg8::gemm_phase<pg8::EpiQKV, pg8::DenseOrder, true, true, true>(Fr.lds, S, E, &hj);
        }
        if (BOTH(8)) GRID_BAR();
    }
    if (IN(9)) {
        Fr.refresh();
        REP(9) {
        for (int W = Fr.vcu; W < NB * NH * (T / 256); W += Fr.G) { const int bh = W >> 4, g = W & 15;
            attn_wg_task(Fr, bh / NH, bh % NH, g, R0, R1, R2, XN); }
        }
        if (BOTH(9)) GRID_BAR();
    }
    if (IN(10)) {
        Fr.refresh();
        pg8::DenseOrder S; S.init(XN, WOUT1, M, D, D, Fr.G, (int)blockIdx.x, 1);
        pg8::EpiResid<false> E{Hs, Hs};
        const L1Split sp = l1_split(Fr.vcu, Fr.G, (int)blockIdx.x);
        const int r10 = sp.n1 - sp.c3 - sp.c8;
        HostJob hj{1, Fr.vcu + (r10 > 0 ? sp.c3 + sp.c8 : 0) * Fr.G, Fr.G, 0, r10 > 0 ? r10 : 1};
        host_build_table(hj, Fr.lds, Fr.tid);
        const int hd = pg8::gemm_phase<pg8::EpiResid<false>, pg8::DenseOrder, true, true, true>(Fr.lds, S, E, &hj);
        Fr.refresh();
        host_leftover(hj, hd, (LAS float*)(Fr.lds + Fr.wave * 16896), Fr.wave, lane);
        if (BOTH(10)) GRID_BAR();
    }
    if (IN(11)) {
        Fr.refresh();
        router_phase(Fr, 1, 1, M / 16, norm_ffn_g + D, Hs, XN, RW, rgb, reb, ctl, LTOK, LGATE, LRSTD);
        if (BOTH(11)) GRID_BAR();
    }
    if (IN(12)) {
        Fr.refresh();
        REP(12) {
        const int nu = build_tab(Fr, gtab, ctl, 1, 4);
        pg8::GroupedOrder<true> S; S.A = XN; S.Bt = ws + WS_WGU1; S.ltok = LTOK; S.tab = gtab; S.K = D; S.rowb = D; S.wscale = 0; S.NCT = 4; S.nunits = nu; S.G = Fr.G; S.c = (int)blockIdx.x; S.bstride = (size_t)1024 * D;
        S.tokl = (const LAS int*)(Fr.lds + 131072); pg8::prefill_tokens(S, (LAS int*)(Fr.lds + 131072), (LAS float*)(Fr.lds + 131072 + 6144), LRSTD, 6, false);
        pg8::EpiGateUp E{(unsigned char*)HG, (const LAS float*)(Fr.lds + 131072 + 6144)};
        pg8::gemm_phase<pg8::EpiGateUp, pg8::GroupedOrder<true>, true, true>(Fr.lds, S, E);
        }
        if (BOTH(12)) GRID_BAR();
    }
    if (IN(13)) {
        Fr.refresh();
        REP(13) {
        const int nu = build_tab(Fr, gtab, ctl, 1, 8);
        pg8::GroupedOrder<false> S; S.A = HG; S.Bt = ws + WS_WD1; S.ltok = LTOK; S.tab = gtab; S.K = F; S.rowb = F; S.wscale = 0; S.NCT = 8; S.nunits = nu; S.G = Fr.G; S.c = (int)blockIdx.x; S.bstride = (size_t)D * F; S.tokl = nullptr;
        pg8::prefill_tokens(S, (LAS int*)(Fr.lds + 131072), (LAS float*)(Fr.lds + 131072 + 7168), LGATE, 7, true);
        pg8::EpiDown E{R0, R1, (const LAS int*)(Fr.lds + 131072), (const LAS float*)(Fr.lds + 131072 + 7168)};
        pg8::gemm_phase<pg8::EpiDown, pg8::GroupedOrder<false>, true, true>(Fr.lds, S, E);
        }
        if (BOTH(13)) GRID_BAR();
    }
    if (IN(14)) {
        Fr.refresh();
        REP(14) {
        unsigned bad = 0u;
        if (MK_N_LAUNCHES == 1) bad = __hip_atomic_load(ctl + CW_BAR + XB_TMO, RLX_AGENT);
        {
#define P14_LOAD(m_, h_, a_, c_) do { const u32x2* hr_ = (const u32x2*)(Hs + (size_t)(m_) * D) + lane; const u32x2* y0_ = (const u32x2*)(R0 + (size_t)(m_) * D) + lane; const u32x2* y1_ = (const u32x2*)(R1 + (size_t)(m_) * D) + lane; \
            _Pragma("unroll") for (int j = 0; j < 8; ++j) { h_[j] = hr_[64 * j]; a_[j] = y0_[64 * j]; c_[j] = y1_[64 * j]; } } while (0)
#define P14_DO(m_, h_, a_, c_) do { f32x4 v[8]; float s = 0.f; \
            _Pragma("unroll") for (int j = 0; j < 8; ++j) { const u32x2 h = h_[j], a = a_[j], c = c_[j]; \
                v[j].x = (bflo(h.x) + bflo(a.x)) + bflo(c.x); v[j].y = (bfhi(h.x) + bfhi(a.x)) + bfhi(c.x); v[j].z = (bflo(h.y) + bflo(a.y)) + bflo(c.y); v[j].w = (bfhi(h.y) + bfhi(a.y)) + bfhi(c.y); \
                s += (v[j].x * v[j].x + v[j].y * v[j].y) + (v[j].z * v[j].z + v[j].w * v[j].w); } \
            float rstd = __builtin_amdgcn_rsqf(wave_sum(s) * (1.f / D) + EPS); if (bad) rstd = __builtin_nanf(""); \
            _Pragma("unroll") for (int j = 0; j < 8; ++j) { const f32x4 g = *((const f32x4*)final_g + lane + 64 * j); f32x4 o; o.x = v[j].x * rstd * g.x; o.y = v[j].y * rstd * g.y; o.z = v[j].z * rstd * g.z; o.w = v[j].w * rstd * g.w; \
                *((f32x4*)(out + (size_t)(m_) * D) + lane + 64 * j) = o; } } while (0)
            u32x2 ha[8], aa[8], ca[8], hb[8], ab[8], cb[8];
            if (gw < M) P14_LOAD(gw, ha, aa, ca);
            for (int m = gw; m < M; m += 2 * NGW) {
                const int m1 = m + NGW, m2 = m + 2 * NGW;
                if (m1 < M) P14_LOAD(m1, hb, ab, cb);
                P14_DO(m, ha, aa, ca);
                if (m1 >= M) break;
                if (m2 < M) P14_LOAD(m2, ha, aa, ca);
                P14_DO(m1, hb, ab, cb);
            }
#undef P14_LOAD
#undef P14_DO
        }
        }
    }
#undef gw
#undef lane
#undef IN
#undef BOTH
#undef GRID_BAR
}

extern "C" void kernel_launch(void* const* d_in, const int* in_sizes, int n_in, void* d_out, int out_size, void* d_ws, size_t ws_size, hipStream_t stream) {
    static int grid = 0;
    if (grid == 0) {
        if (n_in != 17 || in_sizes[0] != M * D || out_size != M * D || ws_size < WS_END) { fprintf(stderr, "kernel_launch: unexpected shapes (n_in %d, in0 %d, out %d, ws %zu)\n", n_in, n_in > 0 ? in_sizes[0] : -1, out_size, ws_size); grid = -1; return; }
        int dev = 0, cus = 0, per_cu = 0;
        if (hipGetDevice(&dev) != hipSuccess || hipDeviceGetAttribute(&cus, hipDeviceAttributeMultiprocessorCount, dev) != hipSuccess) { grid = -1; return; }
        if (hipFuncSetAttribute((const void*)fwd_kernel, hipFuncAttributeMaxDynamicSharedMemorySize, LDS_BYTES) != hipSuccess) { fprintf(stderr, "kernel_launch: hipFuncSetAttribute failed\n"); grid = -1; return; }
        if (hipOccupancyMaxActiveBlocksPerMultiprocessor(&per_cu, (const void*)fwd_kernel, NWAVES * 64, LDS_BYTES) != hipSuccess || per_cu < 1) fprintf(stderr, "kernel_launch: occupancy query reports %d\n", per_cu);
        (void)hipGetLastError();
        grid = cus;
    }
    if (grid < 0) return;
    (void)hipMemsetAsync((char*)d_ws + WS_CTL, 0, CTL_ZERO_BYTES, stream);
    Args a{};
    for (int i = 0; i < 17; ++i) a.in[i] = (const float*)d_in[i];
    a.out = (float*)d_out; a.ws = (unsigned char*)d_ws;
    if (MK_N_LAUNCHES == 1) { a.ph_lo = 0; a.ph_hi = NPH; hipLaunchKernelGGL(fwd_kernel, dim3(grid), dim3(NWAVES * 64), LDS_BYTES, stream, a); }
    else for (int p = 0; p < NPH; ++p) { a.ph_lo = p; a.ph_hi = p + 1; hipLaunchKernelGGL(fwd_kernel, dim3(grid), dim3(NWAVES * 64), LDS_BYTES, stream, a); }
    const hipError_t le = hipPeekAtLastError();
    if (le != hipSuccess) fprintf(stderr, "kernel_launch: launch failed: %s\n", hipGetErrorName(le));
}
```

```cpp
#include <hip/hip_runtime.h>
#include <cstdio>
#include <cstdint>

#ifndef MK_N_LAUNCHES
#define MK_N_LAUNCHES 1
#endif
#ifndef ATTN_EARLY_EXIT
#define ATTN_EARLY_EXIT 1
#endif

#ifndef PROBE_DUP
#define PROBE_DUP 0
#endif
#define GAS __attribute__((address_space(1)))
#define LAS __attribute__((address_space(3)))
typedef unsigned short bf16;
typedef short bf16x8 __attribute__((ext_vector_type(8)));
typedef short s16x4 __attribute__((ext_vector_type(4)));
typedef float f32x4 __attribute__((ext_vector_type(4)));
typedef float f32x16 __attribute__((ext_vector_type(16)));
typedef unsigned u32x4 __attribute__((ext_vector_type(4)));
typedef unsigned u32x2 __attribute__((ext_vector_type(2)));
typedef float f32x2_t __attribute__((ext_vector_type(2)));
typedef __bf16 bf16x2_t __attribute__((ext_vector_type(2)));
typedef GAS unsigned gu32;
typedef int v4i_t __attribute__((ext_vector_type(4)));
typedef int v8i_t __attribute__((ext_vector_type(8)));

constexpr int D = 2048, NB = 4, T = 4096, NMETA = 16, M = NB * T, MT = M + NMETA, NH = 16, HD = 128;
constexpr int NE = 32, NG = 4, EPG = 8, F = 512, CAP = 16640;
constexpr float EPS = 1e-6f;
constexpr float QSCALE = 0.08838834764831845f * 1.4426950408889634f;
constexpr int NPH = 15;
constexpr int NWAVES = 8;

constexpr size_t MiB = 1u << 20;
constexpr size_t WS_CTL = 0, CTL_ZERO_BYTES = 1 * MiB;
constexpr size_t WS_WIN0 = 2 * MiB, WS_WOUT0 = 26 * MiB, WS_WQKV = 34 * MiB, WS_WOUT1 = 58 * MiB;
constexpr size_t WS_WGU0 = 66 * MiB, WS_WD0 = 194 * MiB, WS_WGU1 = 258 * MiB, WS_WD1 = 386 * MiB;
constexpr size_t WS_RW = 450 * MiB;
constexpr size_t WS_XN = 452 * MiB;
constexpr size_t WS_R0 = 517 * MiB, WS_R1 = 582 * MiB, WS_R2 = 647 * MiB;
constexpr size_t WS_H = 712 * MiB;
constexpr size_t WS_HG = 841 * MiB;
constexpr size_t WS_LTOK = 882 * MiB, WS_LGATE = 885 * MiB, WS_LRSTD = 888 * MiB;
constexpr size_t WS_MSCR = 891 * MiB;
constexpr size_t WS_END = 892 * MiB;
static_assert((size_t)MT * D * 2 <= 65 * MiB && (size_t)MT * D * 4 <= 129 * MiB && (size_t)40992 * 512 * 2 <= 41 * MiB && (size_t)NE * CAP * 4 <= 3 * MiB, "ws map");
constexpr int CW_TMO = 0;
constexpr int CW_BAR = 4096;
constexpr int CW_CNT = 16384;
constexpr int RING_BYTES = 150528, LDSCTL_OFF = RING_BYTES, MISC_OFF = LDSCTL_OFF + 320, GTAB_OFF = MISC_OFF + 128, LDS_BYTES = 151552, HOST_OFF = 131072, HOST_TAB_OFF = 147456, HOST_TAB_MAX = 160;
static_assert(GTAB_OFF + 512 <= LDS_BYTES, "lds map");

#define RLX_AGENT __ATOMIC_RELAXED, __HIP_MEMORY_SCOPE_AGENT
#define LDS_WAIT() asm volatile("s_waitcnt lgkmcnt(0)" ::: "memory")
#define VM_WAIT() asm volatile("s_waitcnt vmcnt(0)" ::: "memory")

__device__ __forceinline__ unsigned pk2(float lo, float hi) { f32x2_t v = {lo, hi}; bf16x2_t b = __builtin_convertvector(v, bf16x2_t); return __builtin_bit_cast(unsigned, b); }
__device__ __forceinline__ unsigned pk4_fp8(float a, float b, float c, float d) { int w = __builtin_amdgcn_cvt_pk_fp8_f32(a, b, 0, false); w = __builtin_amdgcn_cvt_pk_fp8_f32(c, d, w, true); return (unsigned)w; }
__device__ __forceinline__ size_t t64_off(size_t row, int cb) { return ((((row >> 4) * (size_t)(D * 2 / 64)) + (size_t)(cb >> 6)) << 10) + ((row & 15) << 6) + (cb & 63); }
__device__ __forceinline__ size_t k8_off(size_t row, int col) { return (((row >> 2) * 128 + (size_t)(col >> 4)) * 4 + (row & 3)) * 16 + (col & 15); }
__device__ __forceinline__ size_t qkv_off(size_t row, int col) { return ((row >> 2) * 256 + (size_t)(col >> 3)) * 32 + (row & 3) * 8 + (col & 7); }
__device__ __forceinline__ f32x4 y8(unsigned w) { const f32x2_t lo = __builtin_amdgcn_cvt_pk_f32_fp8((int)w, false), hi = __builtin_amdgcn_cvt_pk_f32_fp8((int)w, true); return (f32x4){lo[0] * 0.0625f, lo[1] * 0.0625f, hi[0] * 0.0625f, hi[1] * 0.0625f}; }
__device__ __forceinline__ float bf2f(unsigned short u) { return __uint_as_float(((unsigned)u) << 16); }
__device__ __forceinline__ float bflo(unsigned u) { return __uint_as_float(u << 16); }
__device__ __forceinline__ float bfhi(unsigned u) { return __uint_as_float(u & 0xffff0000u); }
__device__ __forceinline__ int opaque_tid() { int t = (int)threadIdx.x; asm volatile("" : "+v"(t)); return t; }
__device__ __forceinline__ float wave_sum(float v) {
#pragma unroll
    for (int o = 1; o < 64; o <<= 1) v += __shfl_xor(v, o);
    return v;
}


struct HostJob { int layer, first, stride, i0, n; };
struct HostItem { const float* src; unsigned char* dst; int N, K; };
__device__ __forceinline__ HostItem host_item(const HostJob& hj, int i);
namespace pg8 {
constexpr int BM = 256, BK = 64, HALF = 128, HTB = HALF * BK * 2, STAGE_BYTES = 8 * HTB, NXCD = 8, WGM = 4;
__host__ __device__ __forceinline__ int lds_byte(int r, int c) { const int st = (r >> 4) * 2 + (c >> 5), rr = r & 15, cc = c & 31, ob = rr * 64 + cc * 2; return st * 1024 + (ob ^ (((ob >> 9) & 1) << 5)); }
__host__ __device__ __forceinline__ void stage_rc(int b, int& R, int& C) { const int st = b / 1024, sb = b % 1024, swz = sb ^ (((sb >> 9) & 1) << 5); R = (st >> 1) * 16 + swz / 64; C = (st & 1) * 32 + (swz % 64) / 2; }
__host__ __device__ __forceinline__ int perm32(int rho) { const int n = rho >> 4, i = rho & 15; return 8 * (i >> 2) + 4 * n + (i & 3); }

__host__ __device__ __forceinline__ int perm256(int R) { return 64 * ((R >> 5) & 3) + 16 * ((R >> 2) & 3) + 4 * ((R >> 4) & 1) + (R & 3); }

struct Unit { int pm, pn, e, rows, rb, li; };

__device__ __forceinline__ int xcd_remap(int L, int nwg) { const int q = nwg / NXCD, r = nwg % NXCD, xcd = L % NXCD, off = L / NXCD; return (xcd < r ? xcd * (q + 1) : r * (q + 1) + (xcd - r) * q) + off; }

template <bool TILED> struct DenseOrderT {
    static constexpr bool VAR_A = false;
    const bf16* A; const bf16* Bt; int K, rowb, wscale, nM, nN, nwg, G, c;
    __device__ __forceinline__ void init(const bf16* A_, const bf16* Bt_, int Mrows, int N, int K_, int G_, int c_, int esz = 2) { A = A_; Bt = Bt_; K = K_; rowb = K_ * esz; wscale = 0; nM = Mrows / BM; nN = N / BM; nwg = nM * nN; G = G_; c = c_; }
    __device__ __forceinline__ bool next(int i, Unit& u) const {
        const long L = (long)i * G + c; if (L >= nwg) return false;
        const int wgid = xcd_remap((int)L, nwg);
        const int nig = WGM * nN, gid = wgid / nig, fm = gid * WGM, gsz = (nM - fm) < WGM ? (nM - fm) : WGM;
        u.pm = fm + ((wgid % nig) % gsz); u.pn = (wgid % nig) / gsz; u.e = 0; u.rows = BM; u.rb = u.pm * BM; u.li = i; return true;
    }
    __device__ __forceinline__ size_t kstep_a() const { return TILED ? (size_t)2048 : (size_t)(BK * 2); }
    __device__ __forceinline__ const char* a_base(const Unit& u) const { return (const char*)A + (size_t)u.pm * BM * rowb; }
    __device__ __forceinline__ const char* b_base(const Unit& u) const { return (const char*)Bt + (size_t)u.pn * BM * rowb; }
    __device__ __forceinline__ void a_off(const Unit&, const int (&R)[2], const int (&C)[2], unsigned (&v)[2][2]) const {
#pragma unroll
        for (int h = 0; h < 2; ++h)
#pragma unroll
            for (int i = 0; i < 2; ++i) { const int r = R[i] + HALF * h; v[h][i] = TILED ? (unsigned)((((r >> 4) * (rowb >> 6) + (C[i] >> 5)) << 10) + ((r & 15) << 6) + ((C[i] * 2) & 63)) : (unsigned)(r * rowb + C[i] * 2); }
    }
};
using DenseOrder = DenseOrderT<false>;
template <bool GATHER> struct GroupedOrder {
    static constexpr bool VAR_A = GATHER;
    __device__ __forceinline__ size_t kstep_a() const { return (size_t)(BK * 2); }
    const void* A; const void* Bt; const int* ltok; const LAS int* tab; const LAS int* tokl; int K, rowb, wscale, NCT, nunits, G, c; size_t bstride;
    __device__ __forceinline__ bool next(int i, Unit& u) const {
        const long L = (long)i * G + c; if (L >= nunits) return false;
        const int wgid = xcd_remap((int)L, nunits);
        const int tl = wgid / NCT; u.pn = wgid % NCT;
        const int ln = (int)(threadIdx.x & 31);
        const int e = __builtin_popcountll(__ballot((threadIdx.x & 63) < 32 && tab[32 + ln] <= tl)) - 1;
        u.e = e; u.pm = tl - tab[32 + e]; const int rem = tab[e] - BM * u.pm; u.rows = rem < BM ? rem : BM; u.rb = tl * BM; u.li = i; return true;
    }
    __device__ __forceinline__ const char* a_base(const Unit& u) const { return GATHER ? (const char*)A : (const char*)A + (size_t)u.rb * rowb; }
    __device__ __forceinline__ const char* b_base(const Unit& u) const { return (const char*)Bt + (size_t)u.e * bstride + (size_t)u.pn * BM * rowb; }
    __device__ __forceinline__ void a_off(const Unit& u, const int (&R)[2], const int (&C)[2], unsigned (&v)[2][2]) const {
#pragma unroll
        for (int h = 0; h < 2; ++h)
#pragma unroll
            for (int i = 0; i < 2; ++i) {
                const int r = R[i] + HALF * h;
                if (GATHER) { const int tok = tokl[u.li * BM + r]; v[h][i] = (unsigned)(tok * rowb + C[i] * 2); }
                else v[h][i] = (unsigned)(r * rowb + C[i] * 2);
            }
    }
};

template <class S> __device__ __forceinline__ void prefill_tokens(const S& sch, LAS int* tokl, LAS float* fl, const float* fsrc, int maxu, bool keepk) {
    Unit u;
    for (int i = 0; i < maxu && sch.next(i, u); ++i)
        for (int r = (int)threadIdx.x; r < BM; r += NWAVES * 64) { const size_t li = (size_t)u.e * CAP + u.pm * BM + r; const bool ok = r < u.rows;
            const int tk = ok ? sch.ltok[li] : 0; tokl[i * BM + r] = keepk ? tk : (tk & 0x7fffffff); fl[i * BM + r] = ok ? fsrc[li] : 0.f; }
    __syncthreads();
}
struct EpiCH {
    static constexpr bool PERM = true;
    bf16* V1;
    __device__ __forceinline__ void operator()(const f32x4 (&acc)[2][2][4][2], const Unit& u, int wr, int wc, int fr, int fq) const {
        const int row0 = u.pm * BM + wr * 64 + fr, col0 = u.pn * HALF + wc * 32 + 8 * fq;
#pragma unroll
        for (int ai = 0; ai < 2; ++ai)
#pragma unroll
            for (int m = 0; m < 4; ++m) { bf16* rowp = (bf16*)((unsigned char*)V1 + t64_off((size_t)(row0 + ai * HALF + m * 16), col0 * 2));
                const f32x4 v0 = acc[ai][0][m][0] * acc[ai][1][m][0], v1 = acc[ai][0][m][1] * acc[ai][1][m][1]; u32x4 w; w.x = pk2(v0[0], v0[1]); w.y = pk2(v0[2], v0[3]); w.z = pk2(v1[0], v1[1]); w.w = pk2(v1[2], v1[3]);
                *(u32x4*)rowp = w; }
    }
};
struct EpiGateConv {
    static constexpr bool PERM = true;
    const bf16* V1; bf16* U; const float* cw; const float* mscr;
    __device__ __forceinline__ void ld8(const bf16* p, float (&o)[8]) const { const u32x4 q = *(const u32x4*)p; o[0] = bflo(q.x); o[1] = bfhi(q.x); o[2] = bflo(q.y); o[3] = bfhi(q.y); o[4] = bflo(q.z); o[5] = bfhi(q.z); o[6] = bflo(q.w); o[7] = bfhi(q.w); }
    __device__ __forceinline__ void meta8(int i, int c0, float (&o)[8]) const {
#pragma unroll
        for (int j = 0; j < 8; ++j) { const int c = c0 + j; const float cv = mscr[i * (3 * D) + D + (c >> 7) * 256 + (c & 127)], hv = mscr[i * (3 * D) + D + (c >> 7) * 256 + 128 + (c & 127)]; o[j] = bf2f((unsigned short)(pk2(cv * hv, 0.f) & 0xffffu)); }
    }
    __device__ __forceinline__ void operator()(const f32x4 (&acc)[2][2][4][2], const Unit& u, int wr, int wc, int fr, int fq) const {
#pragma unroll
        for (int bj = 0; bj < 2; ++bj) {
            const int c0 = u.pn * BM + bj * HALF + wc * 32 + 8 * fq;
            float w0[8], w1[8], w2[8];
#pragma unroll
            for (int j = 0; j < 8; ++j) { w0[j] = cw[c0 + j]; w1[j] = cw[D + c0 + j]; w2[j] = cw[2 * D + c0 + j]; }
#pragma unroll
            for (int ai = 0; ai < 2; ++ai) {
                __builtin_amdgcn_sched_barrier(0);
                const int rb = u.pm * BM + wr * 64 + ai * HALF;
                u32x4 q[5];
                if ((rb & (T - 1)) != 0) q[0] = *(const u32x4*)((const unsigned char*)V1 + t64_off((size_t)(rb - 16 + fr), c0 * 2));
                else { q[0] = (u32x4){0u, 0u, 0u, 0u}; if (fr >= 14) { float mv[8]; meta8(fr, c0, mv); q[0].x = pk2(mv[0], mv[1]); q[0].y = pk2(mv[2], mv[3]); q[0].z = pk2(mv[4], mv[5]); q[0].w = pk2(mv[6], mv[7]); } }
#pragma unroll
                for (int m = 0; m < 4; ++m) q[1 + m] = *(const u32x4*)((const unsigned char*)V1 + t64_off((size_t)(rb + m * 16 + fr), c0 * 2));
#pragma unroll
                for (int m = 0; m < 4; ++m) {
                    const int r = rb + m * 16 + fr;
                    const f32x4 b0 = acc[ai][bj][m][0], b1 = acc[ai][bj][m][1]; u32x4 w;
#pragma unroll
                    for (int d = 0; d < 4; ++d) {
                        const unsigned c = q[1 + m][d], p = q[m][d];
                        const unsigned a1 = __builtin_amdgcn_mov_dpp(c, 0x121, 0xf, 0xf, false), p1 = __builtin_amdgcn_mov_dpp(p, 0x121, 0xf, 0xf, false);
                        const unsigned a2 = __builtin_amdgcn_mov_dpp(c, 0x122, 0xf, 0xf, false), p2 = __builtin_amdgcn_mov_dpp(p, 0x122, 0xf, 0xf, false);
                        const unsigned x1 = fr < 1 ? p1 : a1, x2 = fr < 2 ? p2 : a2;
                        const float bl = d < 2 ? b0[2 * d] : b1[2 * d - 4], bh = d < 2 ? b0[2 * d + 1] : b1[2 * d - 3];
                        const float ol = bl * (w0[2 * d] * bflo(x2) + w1[2 * d] * bflo(x1) + w2[2 * d] * bflo(c)), oh = bh * (w0[2 * d + 1] * bfhi(x2) + w1[2 * d + 1] * bfhi(x1) + w2[2 * d + 1] * bfhi(c));
                        w[d] = pk2(ol, oh);
                    }
                    *(u32x4*)((unsigned char*)U + t64_off((size_t)r, c0 * 2)) = w;
                }
            }
        }
    }
};
struct EpiQKV {
    static constexpr int PERM = 2;
    bf16* Q; size_t stride; float qscale;
    __device__ __forceinline__ void operator()(const f32x4 (&acc)[2][2][4][2], const Unit& u, int wr, int wc, int fr, int fq) const {
        const int row0 = u.pm * BM + wr * 64 + fr; const int t = u.pn >> 3; bf16* base = Q + (size_t)t * stride; const float sc = t == 0 ? qscale * 32.f : 4.f;
        const int col0 = (u.pn & 7) * BM + wc * 64 + 16 * fq;
#pragma unroll
        for (int ai = 0; ai < 2; ++ai)
#pragma unroll
            for (int m = 0; m < 4; ++m) { const size_t row = (size_t)(row0 + ai * HALF + m * 16);
                const f32x4 v0 = acc[ai][0][m][0] * sc, v1 = acc[ai][0][m][1] * sc, v2 = acc[ai][1][m][0] * sc, v3 = acc[ai][1][m][1] * sc;
                { u32x4 w; w.x = pk4_fp8(v0[0], v0[1], v0[2], v0[3]); w.y = pk4_fp8(v1[0], v1[1], v1[2], v1[3]); w.z = pk4_fp8(v2[0], v2[1], v2[2], v2[3]); w.w = pk4_fp8(v3[0], v3[1], v3[2], v3[3]);
                    *(u32x4*)((unsigned char*)base + k8_off(row, col0)) = w; } }
    }
};
template <bool IN_F32> struct EpiResid {
    static constexpr bool PERM = true;
    const void* in; bf16* out;
    __device__ __forceinline__ void operator()(const f32x4 (&acc)[2][2][4][2], const Unit& u, int wr, int wc, int fr, int fq) const {
        const int row0 = u.pm * BM + wr * 64 + fr, col0 = u.pn * BM + wc * 32 + 8 * fq;
        constexpr int GM = IN_F32 ? 2 : 4;
#pragma unroll
        for (int ai = 0; ai < 2; ++ai)
#pragma unroll
            for (int mg = 0; mg < 4; mg += GM) {
                __builtin_amdgcn_sched_barrier(0);
                u32x4 ra[GM][2], rb[GM][2];
#pragma unroll
                for (int mm = 0; mm < GM; ++mm)
#pragma unroll
                    for (int bj = 0; bj < 2; ++bj) { const size_t off = (size_t)(row0 + ai * HALF + (mg + mm) * 16) * D + col0 + bj * HALF;
                        if (IN_F32) { ra[mm][bj] = *(const u32x4*)((const float*)in + off); rb[mm][bj] = *(const u32x4*)((const float*)in + off + 4); }
                        else { ra[mm][bj] = *(const u32x4*)((const bf16*)in + off); rb[mm][bj] = ra[mm][bj]; } }
                __builtin_amdgcn_sched_barrier(0);
#pragma unroll
                for (int mm = 0; mm < GM; ++mm)
#pragma unroll
                    for (int bj = 0; bj < 2; ++bj) { const size_t off = (size_t)(row0 + ai * HALF + (mg + mm) * 16) * D + col0 + bj * HALF; f32x4 b0, b1; const u32x4 q = ra[mm][bj], q2 = rb[mm][bj];
                        if (IN_F32) { b0 = __builtin_bit_cast(f32x4, q); b1 = __builtin_bit_cast(f32x4, q2); }
                        else { b0 = (f32x4){bflo(q.x), bfhi(q.x), bflo(q.y), bfhi(q.y)}; b1 = (f32x4){bflo(q.z), bfhi(q.z), bflo(q.w), bfhi(q.w)}; }
                        const f32x4 v0 = b0 + acc[ai][bj][mg + mm][0], v1 = b1 + acc[ai][bj][mg + mm][1]; u32x4 w; w.x = pk2(v0[0], v0[1]); w.y = pk2(v0[2], v0[3]); w.z = pk2(v1[0], v1[1]); w.w = pk2(v1[2], v1[3]);
                        *(u32x4*)(out + off) = w; }
            }
    }
};
struct EpiGateUp {
    static constexpr bool PERM = true;
    unsigned char* HG; const LAS float* lrstd;
    __device__ __forceinline__ u32x2 hrow(const f32x4 (&acc)[2][2][4][2], int ai, int m, float rs) const {
        float o[8];
#pragma unroll
        for (int n = 0; n < 2; ++n)
#pragma unroll
            for (int j = 0; j < 4; ++j) { const float g = acc[ai][0][m][n][j] * rs, up = acc[ai][1][m][n][j] * rs; o[n * 4 + j] = g * __builtin_amdgcn_rcpf(1.f + __builtin_amdgcn_exp2f(-1.4426950408889634f * g)) * up; }
        u32x2 w; w.x = pk4_fp8(o[0], o[1], o[2], o[3]); w.y = pk4_fp8(o[4], o[5], o[6], o[7]); return w;
    }
    __device__ __forceinline__ void operator()(const f32x4 (&acc)[2][2][4][2], const Unit& u, int wr, int wc, int fr, int fq) const {
        const int row0 = u.rb + wr * 64 + fr, col0 = u.pn * HALF + wc * 32 + 8 * (fq & 2); const int lb = u.li * BM; const bool odd = (fq & 1) != 0;
#pragma unroll
        for (int ai = 0; ai < 2; ++ai)
#pragma unroll
            for (int mp = 0; mp < 2; ++mp) { const int r0 = ai * HALF + wr * 64 + mp * 32 + fr;
                const u32x2 w0 = hrow(acc, ai, 2 * mp, lrstd[lb + r0]), w1 = hrow(acc, ai, 2 * mp + 1, lrstd[lb + r0 + 16]);
                const u32x2 snd = odd ? w0 : w1; u32x2 rcv; rcv.x = (unsigned)__shfl_xor((int)snd.x, 16); rcv.y = (unsigned)__shfl_xor((int)snd.y, 16);
                u32x4 o4; if (odd) { o4.x = rcv.x; o4.y = rcv.y; o4.z = w1.x; o4.w = w1.y; } else { o4.x = w0.x; o4.y = w0.y; o4.z = rcv.x; o4.w = rcv.y; }
                *(u32x4*)(HG + (size_t)(row0 + ai * HALF + (2 * mp + (odd ? 1 : 0)) * 16) * F + col0) = o4; }
    }
};
struct EpiDown {
    static constexpr int PERM = 2;
    unsigned char* Y0; unsigned char* Y1; const LAS int* ltok; const LAS float* lgate;
    __device__ __forceinline__ void operator()(const f32x4 (&acc)[2][2][4][2], const Unit& u, int wr, int wc, int fr, int fq) const {
        const int col0 = u.pn * BM + wc * 64 + 16 * fq; const int lb = u.li * BM;
#pragma unroll
        for (int ai = 0; ai < 2; ++ai)
#pragma unroll
            for (int m = 0; m < 4; ++m) { const int r = ai * HALF + wr * 64 + m * 16 + fr;
                if (r < u.rows) { const int tk = ltok[lb + r]; const float gt = lgate[lb + r] * 16.f; unsigned char* rowp = ((tk < 0) ? Y1 : Y0) + (size_t)(tk & 0x7fffffff) * D + col0;
                    const f32x4 v0 = acc[ai][0][m][0] * gt, v1 = acc[ai][0][m][1] * gt, v2 = acc[ai][1][m][0] * gt, v3 = acc[ai][1][m][1] * gt;
                    u32x4 w; w.x = pk4_fp8(v0[0], v0[1], v0[2], v0[3]); w.y = pk4_fp8(v1[0], v1[1], v1[2], v1[3]); w.z = pk4_fp8(v2[0], v2[1], v2[2], v2[3]); w.w = pk4_fp8(v3[0], v3[1], v3[2], v3[3]);
                    *(u32x4*)rowp = w; } }
    }
};

template <class Epi, class Sched, bool ALIGN_EPI, bool FP8 = false, bool HOST = false>
__device__ __forceinline__ int gemm_phase(LAS unsigned char* lds, const Sched& S, const Epi& E, const HostJob* hjp = nullptr) {
    const int tid = opaque_tid(), wid = __builtin_amdgcn_readfirstlane(tid >> 6), lane = tid & 63, wr = wid >> 2, wc = wid & 3, fr = lane & 15, fq = lane >> 4;
    const int rowb = S.rowb, nt = rowb / (BK * 2);
    int RR[2], CC[2]; unsigned voffB[2];
#pragma unroll
    for (int i = 0; i < 2; ++i) { int R, C; stage_rc(tid * 16 + i * 8192, R, C); RR[i] = R; CC[i] = C; const int Rb = (int)Epi::PERM == 2 ? perm256(R) : Epi::PERM ? ((R & ~31) + perm32(R & 31)) : R; voffB[i] = (unsigned)(Rb * rowb + C * 2); }
    const size_t kstep = (size_t)(BK * 2), kstepA = S.kstep_a();
    const size_t hstep = (size_t)((int)Epi::PERM == 2 ? 8 : HALF) * rowb;
    const unsigned ldsw = (unsigned)wid * 1024u;
    const int aoff = FP8 ? lds_byte(wr * 64 + fr, (fq >> 1) * 32 + (fq & 1) * 16) : lds_byte(wr * 64 + fr, fq * 8), boff = FP8 ? lds_byte(wc * 32 + fr, (fq >> 1) * 32 + (fq & 1) * 16) : lds_byte(wc * 32 + fr, fq * 8);
#define PG8_SA(b, h) (((b) * 2 + (h)) * HTB)
#define PG8_SB(b, h) ((4 + (b) * 2 + (h)) * HTB)
#define PG8_STAGE(bufoff, gbase, voff) do { _Pragma("unroll") for (int _i = 0; _i < 2; ++_i) \
        __builtin_amdgcn_global_load_lds((const unsigned*)((const char*)(gbase) + (voff)[_i]), (LAS unsigned*)(lds + (bufoff) + ldsw + _i * 8192), 16, 0, 0); } while (0)
#define PG8_LDA(dst, b, h) do { _Pragma("unroll") for (int m = 0; m < 4; ++m) _Pragma("unroll") for (int k = 0; k < 2; ++k) dst[m][k] = *(const LAS bf16x8*)(lds + PG8_SA(b, h) + aoff + m * 2048 + (FP8 ? k * 16 : k * 1024)); } while (0)
#define PG8_LDB(dst, b, h) do { _Pragma("unroll") for (int n = 0; n < 2; ++n) _Pragma("unroll") for (int k = 0; k < 2; ++k) dst[n][k] = *(const LAS bf16x8*)(lds + PG8_SB(b, h) + boff + n * 2048 + (FP8 ? k * 16 : k * 1024)); } while (0)
#define PG8_CAT8(x) __builtin_shufflevector(__builtin_bit_cast(v4i_t, x[0]), __builtin_bit_cast(v4i_t, x[1]), 0, 1, 2, 3, 4, 5, 6, 7)
#define PG8_MMA(ai, bj, At, Bt) do { __builtin_amdgcn_s_setprio(1); \
        if constexpr (FP8) { _Pragma("unroll") for (int m = 0; m < 4; ++m) _Pragma("unroll") for (int n = 0; n < 2; ++n) \
            asm("v_mfma_scale_f32_16x16x128_f8f6f4 %0, %1, %2, %0, %3, %3 op_sel_hi:[0,0,0]" : "+v"(acc[ai][bj][m][n]) : "v"(PG8_CAT8(Bt[n])), "v"(PG8_CAT8(At[m])), "v"(sc8)); } \
        else { _Pragma("unroll") for (int m = 0; m < 4; ++m) _Pragma("unroll") for (int n = 0; n < 2; ++n) _Pragma("unroll") for (int k = 0; k < 2; ++k) \
            acc[ai][bj][m][n] = __builtin_amdgcn_mfma_f32_16x16x32_bf16(Bt[n][k], At[m][k], acc[ai][bj][m][n], 0, 0, 0); } \
        __builtin_amdgcn_s_setprio(0); } while (0)
#define PG8_WAIT_V(n) asm volatile("s_waitcnt vmcnt(" #n ")" ::: "memory")
#define PG8_WAIT_L(n) asm volatile("s_waitcnt lgkmcnt(" #n ")" ::: "memory")
#define PG8_BAR __builtin_amdgcn_s_barrier()
#define PG8_SCHED __builtin_amdgcn_sched_barrier(0)
    Unit cur, nxt; int ui = 0;
    if (!S.next(0, cur)) return 0;
    const int sc8 = 0x7d7d7d7d;
    f32x4 acc[2][2][4][2];
#pragma unroll
    for (int a = 0; a < 2; ++a)
#pragma unroll
        for (int b = 0; b < 2; ++b)
#pragma unroll
            for (int m = 0; m < 4; ++m)
#pragma unroll
                for (int n = 0; n < 2; ++n) acc[a][b][m][n] = (f32x4){0.f, 0.f, 0.f, 0.f};
    bf16x8 At[4][2], B0[2][2], B1[2][2];
    unsigned vc[2][2], vn[2][2];
    S.a_off(cur, RR, CC, vc);
    const char* cA = S.a_base(cur); const char* cB = S.b_base(cur);
    int hdone = 0; const int hn = HOST ? (hjp->n < HOST_TAB_MAX ? hjp->n : HOST_TAB_MAX) : 0;
    const int htab = (int)(unsigned)(size_t)(lds + HOST_TAB_OFF);
#define PG8_HOST_ISSUE(d_) do { int ln_ = lane; asm volatile("" : "+v"(ln_)); const int sh_ = ((d_).z & 1u) ? 13 : 11;     \
        const unsigned long long sb_ = ((unsigned long long)(d_).y << 32) | (d_).x; \
        _Pragma("unroll") for (int q_ = 0; q_ < 2; ++q_) { const int j_ = 2 * wid + q_; \
        const float* sp_ = (const float*)((const char*)(size_t)sb_ + ((size_t)(unsigned)((8 * j_ + (ln_ >> 3)) << sh_)) + (((ln_ & 7) ^ (ln_ >> 3)) << 4)); \
        __builtin_amdgcn_global_load_lds((const unsigned*)sp_, (LAS unsigned*)(lds + HOST_OFF + j_ * 1024), 16, 0, 2); } } while (0)
    if constexpr (HOST) { u32x4 d0_; asm volatile("ds_read_b128 %0, %1" : "=v"(d0_) : "v"(htab) : "memory"); asm volatile("s_waitcnt lgkmcnt(0)" : "+v"(d0_) :: "memory"); PG8_HOST_ISSUE(d0_); }
    PG8_STAGE(PG8_SB(0, 0), cB, voffB); PG8_STAGE(PG8_SB(0, 1), cB + hstep, voffB); PG8_STAGE(PG8_SA(0, 0), cA, vc[0]); PG8_STAGE(PG8_SA(0, 1), cA, vc[1]);
    if (wr == 1) PG8_BAR;
    PG8_WAIT_V(2); PG8_BAR;
    PG8_STAGE(PG8_SB(1, 0), cB + kstep, voffB); PG8_STAGE(PG8_SA(1, 0), cA + kstepA, vc[0]); PG8_STAGE(PG8_SB(1, 1), cB + hstep + kstep, voffB);
    PG8_WAIT_V(6); PG8_BAR;
    for (;;) {
        const bool has_next = S.next(ui + 1, nxt);
        const char* nA = cA; const char* nB = cB;
#pragma unroll
        for (int h = 0; h < 2; ++h)
#pragma unroll
            for (int i = 0; i < 2; ++i) vn[h][i] = vc[h][i];
        if (has_next) { nA = S.a_base(nxt); nB = S.b_base(nxt); if constexpr (Sched::VAR_A) S.a_off(nxt, RR, CC, vn); }
        for (int t = 0; t < nt; t += 2) {
            const bool last = (t == nt - 2);
            const char* a1 = cA + (size_t)(t + 1) * kstepA;
            const char* a2 = last ? nA : cA + (size_t)(t + 2) * kstepA; const char* b2 = last ? nB : cB + (size_t)(t + 2) * kstep;
            const char* a3 = a2 + kstepA; const char* b3 = b2 + kstep;
            unsigned w0[2], w1[2];
#pragma unroll
            for (int i = 0; i < 2; ++i) { if constexpr (Sched::VAR_A) { w0[i] = last ? vn[0][i] : vc[0][i]; w1[i] = last ? vn[1][i] : vc[1][i]; } else { w0[i] = vc[0][i]; w1[i] = vc[1][i]; } }
            float hv_[8]; u32x4 hdc_, hdn_;
            PG8_LDB(B0, 0, 0); PG8_LDB(B1, 0, 1); PG8_SCHED; PG8_LDA(At, 0, 0); PG8_STAGE(PG8_SA(1, 1), a1, vc[1]);
            if constexpr (HOST) { PG8_WAIT_V(9); } else { PG8_WAIT_V(8); }
            PG8_WAIT_L(0); PG8_BAR; PG8_MMA(0, 0, At, B0); PG8_MMA(0, 1, At, B1); PG8_BAR; PG8_SCHED;
            PG8_LDA(At, 0, 1);
            int ht_ = tid; if constexpr (HOST) asm volatile("" : "+v"(ht_));
            const int hT = ht_ & 31, hkg = ht_ >> 5;
            if constexpr (HOST) { const int hrd = (int)(unsigned)(size_t)(lds + HOST_OFF) + hkg * 1024 + (hT & 3) * 4;
                _Pragma("unroll") for (int q_ = 0; q_ < 8; ++q_) asm volatile("ds_read_b32 %0, %1 offset:%c2" : "=v"(hv_[q_]) : "v"(hrd + ((((hT >> 2) ^ q_) & 7) << 4)), "i"(q_ * 128) : "memory");
                const int ic_ = hdone < hn ? hdone : hn - 1, in_ = hdone + 1 < hn ? hdone + 1 : hn - 1;
                asm volatile("ds_read_b128 %0, %1" : "=v"(hdc_) : "v"(htab + ic_ * 16) : "memory"); asm volatile("ds_read_b128 %0, %1" : "=v"(hdn_) : "v"(htab + in_ * 16) : "memory"); }
            PG8_STAGE(PG8_SB(0, 0), b2, voffB); PG8_STAGE(PG8_SB(0, 1), b2 + hstep, voffB); PG8_STAGE(PG8_SA(0, 0), a2, w0);
            PG8_WAIT_V(8); PG8_WAIT_L(0);
            if constexpr (HOST) { asm volatile("" : "+v"(hv_[0]), "+v"(hv_[1]), "+v"(hv_[2]), "+v"(hv_[3]), "+v"(hv_[4]), "+v"(hv_[5]), "+v"(hv_[6]), "+v"(hv_[7])); asm volatile("" : "+v"(hdc_), "+v"(hdn_)); }
            PG8_BAR; PG8_MMA(1, 0, At, B0); PG8_MMA(1, 1, At, B1); PG8_BAR; PG8_SCHED;
            if constexpr (HOST) { ++hdone; PG8_HOST_ISSUE(hdn_); }
            PG8_LDB(B0, 1, 0); PG8_LDB(B1, 1, 1); PG8_SCHED; PG8_LDA(At, 1, 0); PG8_STAGE(PG8_SA(0, 1), a2, w1);
            if constexpr (HOST) { PG8_WAIT_V(10); } else { PG8_WAIT_V(8); }
            PG8_WAIT_L(0); PG8_BAR; PG8_MMA(0, 0, At, B0); PG8_MMA(0, 1, At, B1); PG8_BAR; PG8_SCHED;
            PG8_LDA(At, 1, 1); PG8_STAGE(PG8_SB(1, 0), b3, voffB); PG8_STAGE(PG8_SB(1, 1), b3 + hstep, voffB); PG8_STAGE(PG8_SA(1, 0), a3, w0);
            if constexpr (HOST) { u32x2 hw_; hw_.x = pk4_fp8(hv_[0] * 16.f, hv_[1] * 16.f, hv_[2] * 16.f, hv_[3] * 16.f); hw_.y = pk4_fp8(hv_[4] * 16.f, hv_[5] * 16.f, hv_[6] * 16.f, hv_[7] * 16.f);
                const unsigned long long db_ = (((unsigned long long)hdc_.w << 32) | hdc_.z) & ~1ull; const int ks_ = (hdc_.z & 1u) ? 9 : 11;
                *(GAS u32x2*)((unsigned char*)(size_t)db_ + (size_t)(unsigned)((hT << ks_) + 8 * hkg)) = hw_;
                PG8_WAIT_V(11); } else { PG8_WAIT_V(8); }
            PG8_WAIT_L(0); PG8_BAR; PG8_MMA(1, 0, At, B0); PG8_MMA(1, 1, At, B1); PG8_BAR; PG8_SCHED;
        }
        if constexpr (ALIGN_EPI) { if (wr == 0) PG8_BAR; }
        if constexpr (FP8) asm volatile("s_nop 15\n\ts_nop 7" ::: "memory");
        E(acc, cur, wr, wc, fr, fq);
        if (!has_next) break;
#pragma unroll
        for (int a = 0; a < 2; ++a)
#pragma unroll
            for (int b = 0; b < 2; ++b)
#pragma unroll
                for (int m = 0; m < 4; ++m)
#pragma unroll
                    for (int n = 0; n < 2; ++n) acc[a][b][m][n] = (f32x4){0.f, 0.f, 0.f, 0.f};
        cur = nxt; cA = nA; cB = nB; ++ui;
#pragma unroll
        for (int h = 0; h < 2; ++h)
#pragma unroll
            for (int i = 0; i < 2; ++i) vc[h][i] = vn[h][i];
        if constexpr (ALIGN_EPI) { if (wr == 1) PG8_BAR; }
    }
    PG8_WAIT_V(0);
    if constexpr (!ALIGN_EPI) { if (wr == 0) PG8_BAR; }
    PG8_BAR;
#undef PG8_HOST_ISSUE
    return hdone < hn ? hdone : hn;
#undef PG8_SA
#undef PG8_SB
#undef PG8_STAGE
#undef PG8_LDA
#undef PG8_LDB
#undef PG8_MMA
#undef PG8_CAT8
#undef PG8_WAIT_V
#undef PG8_WAIT_L
#undef PG8_BAR
#undef PG8_SCHED
}
}

#define XB_TMO      128
#define XB_XCNT(j)  (256  + 64 * (j))
#define XB_XSUB(j)  (1280 + 64 * (j))
#define XB_XGEN(j)  (2304 + 64 * (j))
#define XB_TOP      3328
#define XB_TOPGEN   3392
#define XCD_BAR_WORDS 3456
#define XB_SPIN_CAP (1u << 18)
__device__ __forceinline__ unsigned xb_ld(unsigned* p)              { return __hip_atomic_load(p, __ATOMIC_RELAXED, __HIP_MEMORY_SCOPE_AGENT); }
__device__ __forceinline__ unsigned xb_add(unsigned* p, unsigned v) { return __hip_atomic_fetch_add(p, v, __ATOMIC_RELAXED, __HIP_MEMORY_SCOPE_AGENT); }
__device__ __forceinline__ unsigned xb_xcc_id() { return (unsigned)__builtin_amdgcn_s_getreg((3 << 11) | 20) & 0xFu; }
#define XB_SPIN(cond, bar) do { unsigned _sp = 0; while (cond) { __builtin_amdgcn_s_sleep(1); \
    if ((++_sp & 255u) == 0u) { if (xb_ld(&(bar)[XB_TMO])) break; if (_sp > XB_SPIN_CAP) { atomicAdd(&(bar)[XB_TMO], 1u); break; } } } } while (0)
struct XcdBarrier { unsigned* bar; unsigned x; volatile LAS unsigned* st; };
__device__ __forceinline__ XcdBarrier xcd_barrier_post(unsigned* bar, volatile LAS unsigned* st) {
    XcdBarrier b; b.bar = bar; b.x = xb_xcc_id(); b.st = st;
    if (threadIdx.x == 0) (void)xb_add(&bar[XB_XCNT(b.x)], 1u);
    return b;
}
__device__ __forceinline__ void xcd_barrier_complete(unsigned* bar, unsigned x, unsigned& nloc, unsigned& nx) {
    const unsigned G = gridDim.x * gridDim.y * gridDim.z;
    unsigned sum, cnt, mine, sp = 0u;
    for (;;) {
        sum = 0u; cnt = 0u; mine = 0u;
#pragma unroll
        for (unsigned j = 0; j < 16; ++j) { const unsigned c = xb_ld(&bar[XB_XCNT(j)]); sum += c; cnt += (c > 0u) ? 1u : 0u; mine = (j == x) ? c : mine; }
        if (sum == G) break;
        __builtin_amdgcn_s_sleep(1);
        if ((++sp & 255u) == 0u) { if (xb_ld(&bar[XB_TMO])) break; if (sp > XB_SPIN_CAP) { atomicAdd(&bar[XB_TMO], 1u); break; } }
    }
    nloc = mine > 0u ? mine : 1u; nx = cnt > 0u ? cnt : 1u;
}
__device__ __forceinline__ void xcd_barrier(const XcdBarrier& b) {
    asm volatile("s_waitcnt vmcnt(0)" ::: "memory");
    __syncthreads();
    if (threadIdx.x == 0) {
        unsigned* bar = b.bar;
        __builtin_amdgcn_s_waitcnt(0);
        unsigned nloc = b.st[0], nx = b.st[1];
        if (nloc == 0u) { xcd_barrier_complete(bar, b.x, nloc, nx); b.st[0] = nloc; b.st[1] = nx; }
        const unsigned old = xb_add(&bar[XB_XSUB(b.x)], 1u);
        const unsigned gen = old / nloc;
        if (old + 1u == (gen + 1u) * nloc) {
            __builtin_amdgcn_fence(__ATOMIC_RELEASE, "agent");
            asm volatile("s_waitcnt vmcnt(0)" ::: "memory");
            const unsigned og = xb_add(&bar[XB_TOP], 1u);
            const unsigned tg = og / nx;
            if (og + 1u == (tg + 1u) * nx) xb_add(&bar[XB_TOPGEN], 1u);
            else XB_SPIN(xb_ld(&bar[XB_TOPGEN]) == tg, bar);
            __builtin_amdgcn_fence(__ATOMIC_ACQUIRE, "agent");
            xb_add(&bar[XB_XGEN(b.x)], 1u);
            asm volatile("s_waitcnt vmcnt(0)" ::: "memory");
        } else {
            XB_SPIN(xb_ld(&bar[XB_XGEN(b.x)]) == gen, bar);
            __builtin_amdgcn_fence(__ATOMIC_ACQUIRE, "agent");
            asm volatile("s_waitcnt vmcnt(0)" ::: "memory");
        }
    }
    __syncthreads();
}

struct Frame {
    LAS unsigned char* lds;
    int tid, lane, wave, vcu, G;
    __device__ __forceinline__ void refresh() { tid = opaque_tid(); lane = tid & 63; wave = __builtin_amdgcn_readfirstlane(tid >> 6); }
};

struct TrItem { const float* src; unsigned char* dst; int N, K; float mul; };
__device__ __forceinline__ void tr_load(const TrItem& it, f32x4 (&v)[16], int lane) {
    const float* p = it.src + (size_t)(lane >> 4) * it.N + (lane & 15) * 4;
#pragma unroll
    for (int i = 0; i < 16; ++i) v[i] = __builtin_nontemporal_load((const f32x4*)(p + (size_t)(4 * i) * it.N));
}
__device__ __forceinline__ void tr_finish(const TrItem& it, const f32x4 (&v)[16], LAS float* scr, int lane) {
    { LAS float* w = scr + (lane >> 4) * 65 + (lane & 15) * 4;
#pragma unroll
      for (int i = 0; i < 16; ++i) { w[(4 * i) * 65 + 0] = v[i].x; w[(4 * i) * 65 + 1] = v[i].y; w[(4 * i) * 65 + 2] = v[i].z; w[(4 * i) * 65 + 3] = v[i].w; } }
    LDS_WAIT(); asm volatile("" ::: "memory");
    const int c = lane & 7;
#pragma unroll
    for (int j = 0; j < 8; ++j) { const int n = (lane >> 3) + 8 * j; const LAS float* r = scr + (8 * c) * 65 + n;
        u32x4 o; o.x = pk2(r[0 * 65], r[1 * 65]); o.y = pk2(r[2 * 65], r[3 * 65]); o.z = pk2(r[4 * 65], r[5 * 65]); o.w = pk2(r[6 * 65], r[7 * 65]);
        *(GAS u32x4*)(it.dst + ((size_t)n * it.K + 8 * c) * 2) = o; }
    LDS_WAIT(); asm volatile("" ::: "memory");
}
__device__ __forceinline__ void tr8_load(const TrItem& it, f32x4 (&v)[16], int lane) {
    const float* p = it.src + (size_t)(lane >> 3) * it.N + (lane & 7) * 4;
#pragma unroll
    for (int i = 0; i < 16; ++i) v[i] = __builtin_nontemporal_load((const f32x4*)(p + (size_t)(8 * i) * it.N));
}
__device__ __forceinline__ void tr8_finish(const TrItem& it, const f32x4 (&v)[16], LAS float* scr, int lane) {
    { LAS float* w = scr + (lane >> 3) * 33 + (lane & 7) * 4;
#pragma unroll
      for (int i = 0; i < 16; ++i) { w[(8 * i) * 33 + 0] = v[i].x; w[(8 * i) * 33 + 1] = v[i].y; w[(8 * i) * 33 + 2] = v[i].z; w[(8 * i) * 33 + 3] = v[i].w; } }
    LDS_WAIT(); asm volatile("" ::: "memory");
    const float ml = it.mul;
#pragma unroll
    for (int j = 0; j < 4; ++j) { const int n = (lane & 15) + 16 * (j >> 1), kc = (lane >> 4) + 4 * (j & 1); const LAS float* r = scr + (16 * kc) * 33 + n;
        u32x4 o;
        o.x = pk4_fp8(r[0 * 33] * ml, r[1 * 33] * ml, r[2 * 33] * ml, r[3 * 33] * ml); o.y = pk4_fp8(r[4 * 33] * ml, r[5 * 33] * ml, r[6 * 33] * ml, r[7 * 33] * ml);
        o.z = pk4_fp8(r[8 * 33] * ml, r[9 * 33] * ml, r[10 * 33] * ml, r[11 * 33] * ml); o.w = pk4_fp8(r[12 * 33] * ml, r[13 * 33] * ml, r[14 * 33] * ml, r[15 * 33] * ml);
        *(GAS u32x4*)(it.dst + (size_t)n * it.K + 16 * kc) = o; }
    LDS_WAIT(); asm volatile("" ::: "memory");
}
__device__ __forceinline__ int pair_row(int j, int p) { return (j >> 7) * 256 + p * 128 + (j & 127); }
__device__ __forceinline__ TrItem moe_item(unsigned char* ws, const float* wg, const float* wu, const float* wd, int l, int r) {
    TrItem t; const int p = r >> 13, rr = r & 8191, e = rr >> 8, q = rr & 255, le = l * NE + e;
    if (p < 2) { const int kb = q >> 4, n0 = (q & 15) * 32; unsigned char* dstm = ws + (l == 0 ? WS_WGU0 : WS_WGU1) + (size_t)e * 1024 * D;
        t.src = (p == 0 ? wg : wu) + (size_t)le * D * F + (size_t)kb * 128 * F + n0; t.N = F; t.dst = dstm + (size_t)pair_row(n0, p) * D + kb * 128; t.K = D; }
    else { const int kb = q >> 6, n0 = (q & 63) * 32; unsigned char* dstm = ws + (l == 0 ? WS_WD0 : WS_WD1) + (size_t)e * D * F;
        t.src = wd + (size_t)le * F * D + (size_t)kb * 128 * D + n0; t.N = D; t.dst = dstm + (size_t)n0 * F + kb * 128; t.K = F; }
    t.mul = 16.f; return t;
}
struct Args;
__device__ __forceinline__ void host_ptrs(unsigned char*& ws, const float*& wg, const float*& wu, const float*& wd);
__device__ __forceinline__ HostItem host_item(const HostJob& hj, int i) { unsigned char* ws; const float *wg, *wu, *wd; host_ptrs(ws, wg, wu, wd);
    const TrItem t = moe_item(ws, wg, wu, wd, hj.layer, hj.first + i * hj.stride); HostItem h; h.src = t.src; h.dst = t.dst; h.N = t.N; h.K = t.K; return h; }
__device__ __forceinline__ void host_build_table(const HostJob& hj, LAS unsigned char* lds, int tid) {
    unsigned char* ws; const float *wg, *wu, *wd; host_ptrs(ws, wg, wu, wd);
    for (int i = tid; i < hj.n && i < HOST_TAB_MAX; i += NWAVES * 64) { const TrItem t = moe_item(ws, wg, wu, wd, hj.layer, hj.first + i * hj.stride);
        unsigned long long a = (unsigned long long)(size_t)t.src, b = (unsigned long long)(size_t)t.dst | (t.N == D ? 1ull : 0ull);
        u32x4 e; e.x = (unsigned)a; e.y = (unsigned)(a >> 32); e.z = (unsigned)b; e.w = (unsigned)(b >> 32); *(LAS u32x4*)(lds + HOST_TAB_OFF + i * 16) = e; }
    __syncthreads();
}
__device__ __forceinline__ void host_leftover(const HostJob& hj, int i0, LAS float* scr, int wave, int lane) {
    unsigned char* ws; const float *wg, *wu, *wd; host_ptrs(ws, wg, wu, wd);
    for (int i = i0 + wave; i < hj.n; i += NWAVES) { const TrItem t = moe_item(ws, wg, wu, wd, hj.layer, hj.first + i * hj.stride); f32x4 v[16]; tr8_load(t, v, lane); tr8_finish(t, v, scr, lane); }
}

__device__ __forceinline__ void rms_store_bf16(const f32x4 (&v)[8], const float* gain, bf16* orow, int lane) {
    float s = 0.f;
#pragma unroll
    for (int j = 0; j < 8; ++j) s += (v[j].x * v[j].x + v[j].y * v[j].y) + (v[j].z * v[j].z + v[j].w * v[j].w);
    const float rstd = __builtin_amdgcn_rsqf(wave_sum(s) * (1.f / D) + EPS);
    GAS u32x2* o8 = (GAS u32x2*)orow + lane;
#pragma unroll
    for (int j = 0; j < 8; ++j) { const f32x4 g = *((const f32x4*)gain + lane + 64 * j); u32x2 w; w.x = pk2(v[j].x * rstd * g.x, v[j].y * rstd * g.y); w.y = pk2(v[j].z * rstd * g.z, v[j].w * rstd * g.w); o8[64 * j] = w; }
}

__device__ __forceinline__ void rms_store_fp8(const f32x4 (&v)[8], const float* gain, unsigned char* orow, int lane) {
    float s = 0.f;
#pragma unroll
    for (int j = 0; j < 8; ++j) s += (v[j].x * v[j].x + v[j].y * v[j].y) + (v[j].z * v[j].z + v[j].w * v[j].w);
    const float rstd = __builtin_amdgcn_rsqf(wave_sum(s) * (1.f / D) + EPS);
    GAS unsigned* o4 = (GAS unsigned*)orow + lane;
#pragma unroll
    for (int j = 0; j < 8; ++j) { const f32x4 g = *((const f32x4*)gain + lane + 64 * j); o4[64 * j] = pk4_fp8(v[j].x * rstd * g.x, v[j].y * rstd * g.y, v[j].z * rstd * g.z, v[j].w * rstd * g.w); }
}

template <class EpiM> __device__ __forceinline__ void meta_gemm(Frame& Fr, const bf16* A, const bf16* Bt, int N, int K, const EpiM& epi, int ct0 = 0) {
    LAS float* red = (LAS float*)Fr.lds;
    const int lane = Fr.lane, r16 = lane & 15, kq = lane >> 4, kper = K / NWAVES;
    for (int ct = ct0 + blockIdx.x; ct < N / 16; ct += gridDim.x) {
        f32x4 acc = {0.f, 0.f, 0.f, 0.f};
        const bf16* ap = A + (size_t)r16 * K + Fr.wave * kper + kq * 8;
        const bf16* bp = Bt + (size_t)(ct * 16 + r16) * K + Fr.wave * kper + kq * 8;
#pragma unroll 8
        for (int ks = 0; ks < kper / 32; ++ks) { const bf16x8 a = *(const bf16x8*)(ap + ks * 32), b = *(const bf16x8*)(bp + ks * 32); acc = __builtin_amdgcn_mfma_f32_16x16x32_bf16(a, b, acc, 0, 0, 0); }
#pragma unroll
        for (int r = 0; r < 4; ++r) red[Fr.wave * 256 + (4 * kq + r) * 16 + r16] = acc[r];
        __syncthreads();
        if (Fr.tid < 256) { float s = 0.f;
#pragma unroll
            for (int w = 0; w < NWAVES; ++w) s += red[w * 256 + Fr.tid];
            epi(Fr.tid >> 4, ct * 16 + (Fr.tid & 15), s); }
        __syncthreads();
    }
}


template <class EpiM> __device__ __forceinline__ void meta_gemm8(Frame& Fr, const unsigned char* A, const unsigned char* Bt, int N, int K, const EpiM& epi, int ct0 = 0) {
    LAS float* red = (LAS float*)Fr.lds;
    const int lane = Fr.lane, r16 = lane & 15, kq = lane >> 4, kper = K / NWAVES; const int sc8 = 0x7d7d7d7d;
    for (int ct = ct0 + blockIdx.x; ct < N / 16; ct += gridDim.x) {
        f32x4 acc = {0.f, 0.f, 0.f, 0.f};
        const unsigned char* ap = A + (size_t)r16 * K + Fr.wave * kper + kq * 32;
        const unsigned char* bp = Bt + (size_t)(ct * 16 + r16) * K + Fr.wave * kper + kq * 32;
#pragma unroll 2
        for (int ks = 0; ks < kper / 128; ++ks) { const v8i_t a = *(const v8i_t*)(ap + ks * 128), b = *(const v8i_t*)(bp + ks * 128);
            asm("v_mfma_scale_f32_16x16x128_f8f6f4 %0, %1, %2, %0, %3, %3 op_sel_hi:[0,0,0]" : "+v"(acc) : "v"(a), "v"(b), "v"(sc8)); }
        asm volatile("s_nop 15\n\ts_nop 7" : "+v"(acc) :: "memory");
#pragma unroll
        for (int r = 0; r < 4; ++r) red[Fr.wave * 256 + (4 * kq + r) * 16 + r16] = acc[r];
        __syncthreads();
        if (Fr.tid < 256) { float s = 0.f;
#pragma unroll
            for (int w = 0; w < NWAVES; ++w) s += red[w * 256 + Fr.tid];
            epi(Fr.tid >> 4, ct * 16 + (Fr.tid & 15), s); }
        __syncthreads();
    }
}

__device__ __forceinline__ int crow(int r, int hi) { return (r & 3) + 8 * (r >> 2) + 4 * hi; }
__device__ __forceinline__ void attn_issue_k(int s, int NX, int b, int h, int lane, const bf16* Kb, LAS unsigned char* kt) {
    const bool meta = (s >= NX); const int k0 = (NX - 1 - s) * 32;
#pragma unroll
    for (int i = 0; i < 4; ++i) { const int row = 8 * i + (lane >> 3), slot = lane & 7, chunk = slot ^ ((row >> 1) & 7);
        const size_t grow = meta ? (size_t)(M + (row < NMETA ? row : NMETA - 1)) : (size_t)b * T + k0 + row;
        __builtin_amdgcn_global_load_lds((const unsigned*)((const unsigned char*)Kb + k8_off(grow, h * HD + chunk * 16)), (LAS unsigned*)(kt + i * 1024), 16, 0, 0); }
}
__device__ __forceinline__ void attn_issue_v(int s, int NX, int b, int h, int lane, const bf16* Vb, LAS unsigned char* vt) {
    const bool meta = (s >= NX); const int k0 = (NX - 1 - s) * 32;
#pragma unroll
    for (int i = 0; i < 4; ++i) { const int row = 8 * i + (lane >> 3), slot = lane & 7, f = ((row >> 1) & 1) | (((row >> 3) & 1) << 1), chunk = (((slot >> 1) ^ f) << 1) | (slot & 1);
        const size_t grow = meta ? (size_t)(M + (row < NMETA ? row : NMETA - 1)) : (size_t)b * T + k0 + row;
        __builtin_amdgcn_global_load_lds((const unsigned*)((const unsigned char*)Vb + k8_off(grow, h * HD + chunk * 16)), (LAS unsigned*)(vt + i * 1024), 16, 0, 0); }
}
__device__ __forceinline__ void attn_task(Frame& Fr, int b, int h, int qb, const bf16* Q, const bf16* Kb, const bf16* Vb, bf16* O) {
    const int lane = Fr.lane, r32 = lane & 31, hi = lane >> 5;
    LAS unsigned char* kt = Fr.lds + Fr.wave * 16384; LAS unsigned char* vt = kt + 8192;
    const int tq0 = qb * 32; const size_t qrow0 = (size_t)b * T + tq0;
    u32x2 q8[8];
    { const unsigned char* qp = (const unsigned char*)Q + k8_off(qrow0 + r32, h * HD) + 8 * hi;
#pragma unroll
      for (int d0 = 0; d0 < 8; ++d0) q8[d0] = *(const u32x2*)(qp + d0 * 64); }
    f32x16 o[4];
#pragma unroll
    for (int d0 = 0; d0 < 4; ++d0)
#pragma unroll
        for (int r = 0; r < 16; ++r) o[d0][r] = 0.f;
    float wrun = 1.f;
    const int NX = qb + 1, NS = NX + 1;
    const int kta = (int)(unsigned)(size_t)kt + r32 * 128 + 8 * hi, ky = (r32 >> 1) & 7;
    const int vq = (lane & 15) >> 1, vf = ((vq >> 1) & 1) | (((vq >> 2) & 1) << 1), vta = (int)(unsigned)(size_t)vt + (4 * hi + (vq & 3) + 8 * (vq >> 2)) * 128 + ((lane >> 4) & 1) * 16 + (lane & 1) * 8;
    attn_issue_k(0, NX, b, h, lane, Kb, kt); attn_issue_v(0, NX, b, h, lane, Vb, vt);
    if (NS > 1) { attn_issue_k(1, NX, b, h, lane, Kb, kt + 4096); attn_issue_v(1, NX, b, h, lane, Vb, vt + 4096); }
    for (int s = 0; s < NS; ++s) {
        const bool more = s + 1 < NS, more2 = s + 2 < NS; const int bo = (s & 1) * 4096;
        if (more) asm volatile("s_waitcnt vmcnt(12)" ::: "memory"); else asm volatile("s_waitcnt vmcnt(4)" ::: "memory");
        u32x2 kf[8];
#pragma unroll
        for (int d0 = 0; d0 < 8; ++d0) asm volatile("ds_read_b64 %0, %1" : "=&v"(kf[d0]) : "v"(kta + bo + ((d0 ^ ky) << 4)) : "memory");
        asm volatile("s_waitcnt lgkmcnt(0)" ::: "memory"); __builtin_amdgcn_sched_barrier(0);
        if (more2) attn_issue_k(s + 2, NX, b, h, lane, Kb, kt + bo);
        f32x16 p;
#pragma unroll
        for (int r = 0; r < 16; ++r) p[r] = 0.f;
#pragma unroll
        for (int d0 = 0; d0 < 8; ++d0) p = __builtin_amdgcn_mfma_f32_32x32x16_fp8_fp8(__builtin_bit_cast(long, kf[d0]), __builtin_bit_cast(long, q8[d0]), p, 0, 0, 0);
        const int lim = s == 0 ? r32 : NMETA; const bool need_mask = (s == 0 || s == NX);
#pragma unroll
        for (int r = 0; r < 16; ++r) { float e = __builtin_amdgcn_exp2f(p[r] * 0.0078125f); if (need_mask && crow(r, hi) >= lim) e = 0.f; p[r] = __builtin_amdgcn_rcpf(1.f + e); }
        float gp[4], pg[4], sfx[4];
#pragma unroll
        for (int m = 0; m < 4; ++m) gp[m] = (p[4 * m] * p[4 * m + 1]) * (p[4 * m + 2] * p[4 * m + 3]);
#pragma unroll
        for (int m = 0; m < 4; ++m) pg[m] = __shfl_xor(gp[m], 32);
        float tm = 1.f;
#pragma unroll
        for (int m = 3; m >= 0; --m) { sfx[m] = wrun * (hi == 0 ? tm * pg[m] : tm); tm = tm * (gp[m] * pg[m]); }
        wrun = wrun * tm;
        u32x2 pa[2];
#pragma unroll
        for (int m = 0; m < 4; ++m) {
            const float w0 = p[4 * m], w1 = p[4 * m + 1], w2 = p[4 * m + 2], w3 = p[4 * m + 3];
            const float x3 = sfx[m] * 256.f, x2 = x3 * w3, x1 = x2 * w2, x0 = x1 * w1;
            const unsigned pk = pk4_fp8(x0 * (1.f - w0), x1 * (1.f - w1), x2 * (1.f - w2), x3 * (1.f - w3));
            if (m & 1) pa[m >> 1].y = pk; else pa[m >> 1].x = pk;
        }
        if (more2) asm volatile("s_waitcnt vmcnt(12)" ::: "memory"); else if (more) asm volatile("s_waitcnt vmcnt(8)" ::: "memory"); else asm volatile("s_waitcnt vmcnt(0)" ::: "memory");
#pragma unroll
        for (int d0 = 0; d0 < 4; ++d0) {
            u32x2 bv[2]; const int va = vta + bo + ((d0 ^ vf) << 5);
#pragma unroll
            for (int ks = 0; ks < 2; ++ks) asm volatile("ds_read_b64_tr_b8 %0, %1 offset:%c2" : "=&v"(bv[ks]) : "v"(va), "i"(ks * 2048) : "memory");
            asm volatile("s_waitcnt lgkmcnt(0)" ::: "memory"); __builtin_amdgcn_sched_barrier(0);
#pragma unroll
            for (int ks = 0; ks < 2; ++ks) o[d0] = __builtin_amdgcn_mfma_f32_32x32x16_fp8_fp8(__builtin_bit_cast(long, pa[ks]), __builtin_bit_cast(long, bv[ks]), o[d0], 0, 0, 0);
        }
        const bool dead = ATTN_EARLY_EXIT && !__any(wrun != 0.f);
        if (!more || dead) break;
        if (more2) attn_issue_v(s + 2, NX, b, h, lane, Vb, vt + bo);
    }
    asm volatile("s_waitcnt vmcnt(0)" ::: "memory");
    { LAS unsigned short* ow = (LAS unsigned short*)kt + r32;
#pragma unroll
      for (int d0 = 0; d0 < 4; ++d0)
#pragma unroll
          for (int r = 0; r < 16; ++r) ow[crow(r, hi) * HD + d0 * 32] = (unsigned short)(pk2(o[d0][r] * 0.0009765625f, 0.f) & 0xffffu);
      const LAS u32x4* orr = (const LAS u32x4*)kt + lane; unsigned char* og = (unsigned char*)O + qrow0 * D + h * HD + (lane & 15) * 8;
#pragma unroll
      for (int i = 0; i < 8; ++i) { const u32x4 w = orr[64 * i]; u32x2 w8; w8.x = pk4_fp8(bflo(w.x), bfhi(w.x), bflo(w.y), bfhi(w.y)); w8.y = pk4_fp8(bflo(w.z), bfhi(w.z), bflo(w.w), bfhi(w.w));
          *(u32x2*)(og + (size_t)(4 * i + (lane >> 4)) * D) = w8; } }
}

__device__ __forceinline__ int build_tab(Frame& Fr, LAS int* gtab, gu32* ctl, int l, int nct) {
    if (Fr.tid < 32) gtab[Fr.tid] = (int)__hip_atomic_load(ctl + CW_CNT + (l * 32 + Fr.tid) * 64, RLX_AGENT);
    __syncthreads();
    if (Fr.tid == 0) { int c = 0; for (int e = 0; e < NE; ++e) { gtab[32 + e] = c; c += (gtab[e] + 255) >> 8; } gtab[64] = c; }
    __syncthreads();
    return gtab[64] * nct;
}
__device__ __forceinline__ void rt_issue_h(const bf16* Hs, int row0, int wave, int lane, LAS unsigned char* ht) {
    asm volatile("" : "+v"(lane));
#pragma unroll
    for (int i = 0; i < 8; ++i) { const int row = 2 * i + (lane >> 5), sl = lane & 31, c = sl ^ (row & 15);
        __builtin_amdgcn_global_load_lds((const unsigned*)(Hs + (size_t)(row0 + row) * D + wave * 256 + c * 8), (LAS unsigned*)(ht + i * 1024), 16, 0, 0); }
}
__device__ __forceinline__ void router_phase(Frame& Fr, int l, int cl, int ngroups, const float* gain, const bf16* Hs, bf16* XN, const bf16* RW, const float* rgb, const float* reb, gu32* ctl, int* LTOK, float* LGATE, float* LRSTD) {
    const int lane = Fr.lane, wave = Fr.wave, r16 = lane & 15, kq = lane >> 4, tid = Fr.tid;
    LAS float* gl = (LAS float*)Fr.lds;
    LAS float* part = (LAS float*)(Fr.lds + 8192);
    LAS float* sq = (LAS float*)(Fr.lds + 8192 + 49152);
    LAS float* fin = (LAS float*)(Fr.lds + 8192 + 49152 + 1024);
    LAS float* ssf = (LAS float*)(Fr.lds + 8192 + 49152 + 1024 + 15360);
    LAS unsigned* hist = (LAS unsigned*)(Fr.lds + 8192 + 49152 + 1024 + 15360 + 512);
    LAS unsigned char* ht = Fr.lds + 77824 + wave * 8192;
    for (int i = tid; i < D / 4; i += NWAVES * 64) ((LAS f32x4*)gl)[i] = ((const f32x4*)gain)[i];
    if (tid < 32) hist[tid] = 0u;
    int round = 0, grp = Fr.vcu;
    if (grp < ngroups) rt_issue_h(Hs, grp * 16, wave, lane, ht);
#define RT_KOF(ks) (wave * 256 + ((ks) >> 1) * 64 + kq * 16 + ((ks) & 1) * 8)
    const bf16* whi = RW + (size_t)l * 2 * 48 * D + (size_t)r16 * D;
    bf16x8 wreg[8][3];
#pragma unroll
    for (int ks = 0; ks < 8; ++ks)
#pragma unroll
        for (int c = 0; c < 3; ++c) wreg[ks][c] = *(const bf16x8*)(whi + (size_t)c * 16 * D + RT_KOF(ks));
    __syncthreads();
    if (grp >= ngroups) return;
    for (;;) {
        const int row0 = grp * 16;
        const int nxt = grp + Fr.G; const bool has = nxt < ngroups;
        asm volatile("s_waitcnt vmcnt(0)" ::: "memory");
        u32x4 hv[8];
#pragma unroll
        for (int ks = 0; ks < 8; ++ks) hv[ks] = *(const LAS u32x4*)(ht + r16 * 512 + (((((ks >> 1) * 8 + kq * 2 + (ks & 1)) ^ r16) & 31) << 4));
        asm volatile("s_waitcnt lgkmcnt(0)" ::: "memory");
        if (has) rt_issue_h(Hs, nxt * 16, wave, lane, ht);
        unsigned char* xp = (unsigned char*)XN + (size_t)(row0 + r16) * D + wave * 256 + kq * 16;
        f32x4 acc[3]; float ssq = 0.f; u32x2 x8e;
#pragma unroll
        for (int c = 0; c < 3; ++c) acc[c] = (f32x4){0.f, 0.f, 0.f, 0.f};
#pragma unroll
        for (int ks = 0; ks < 8; ++ks) {
            const u32x4 hq = hv[ks]; const f32x4 h0 = (f32x4){bflo(hq.x), bfhi(hq.x), bflo(hq.y), bfhi(hq.y)}, h1 = (f32x4){bflo(hq.z), bfhi(hq.z), bflo(hq.w), bfhi(hq.w)}, g0 = *(const LAS f32x4*)(gl + RT_KOF(ks)), g1 = *(const LAS f32x4*)(gl + RT_KOF(ks) + 4);
            ssq += ((h0.x * h0.x + h0.y * h0.y) + (h0.z * h0.z + h0.w * h0.w)) + ((h1.x * h1.x + h1.y * h1.y) + (h1.z * h1.z + h1.w * h1.w));
            const float xv[8] = {h0.x * g0.x, h0.y * g0.y, h0.z * g0.z, h0.w * g0.w, h1.x * g1.x, h1.y * g1.y, h1.z * g1.z, h1.w * g1.w};
            { u32x2 x8; x8.x = pk4_fp8(xv[0], xv[1], xv[2], xv[3]); x8.y = pk4_fp8(xv[4], xv[5], xv[6], xv[7]);
              if ((ks & 1) == 0) x8e = x8; else { u32x4 x16; x16.x = x8e.x; x16.y = x8e.y; x16.z = x8.x; x16.w = x8.y; *(u32x4*)(xp + (ks >> 1) * 64) = x16; } }
            const bf16x8 ah = __builtin_bit_cast(bf16x8, hq);
#pragma unroll
            for (int c = 0; c < 3; ++c) acc[c] = __builtin_amdgcn_mfma_f32_16x16x32_bf16(ah, wreg[ks][c], acc[c], 0, 0, 0);
        }
#undef RT_KOF
        ssq += __shfl_xor(ssq, 16); ssq += __shfl_xor(ssq, 32);
        LAS float* pb = part + (round & 1) * (8 * 16 * 48) + wave * (16 * 48);
#pragma unroll
        for (int c = 0; c < 3; ++c)
#pragma unroll
            for (int r = 0; r < 4; ++r) pb[(4 * kq + r) * 48 + c * 16 + r16] = acc[c][r];
        if (kq == 0) sq[(round & 1) * 128 + wave * 16 + r16] = ssq;
        LDS_WAIT(); __builtin_amdgcn_s_barrier(); asm volatile("" ::: "memory");
        for (int t = tid; t < 784; t += NWAVES * 64) {
            if (t < 768) { const LAS float* P = part + (round & 1) * (8 * 16 * 48) + t; float a = 0.f;
#pragma unroll
                for (int w = 0; w < 8; ++w) a += P[w * (16 * 48)];
                fin[round * 768 + t] = a; }
            else { const LAS float* Q = sq + (round & 1) * 128 + (t - 768); float a = 0.f;
#pragma unroll
                for (int w = 0; w < 8; ++w) a += Q[w * 16];
                ssf[round * 16 + (t - 768)] = a; }
        }
        if (!has) break;
        grp = nxt; ++round;
    }
    VM_WAIT(); __syncthreads();
    const int nrows = (round + 1) * 16;
    int tok = 0, e0 = 0, e1 = 0; unsigned k0 = 0, k1 = 0; float g0 = 0.f, g1 = 0.f, rstd = 0.f;
    if (tid < nrows) {
        const int ri = tid >> 4, rr = tid & 15; tok = (Fr.vcu + ri * Fr.G) * 16 + rr;
        const LAS float* L = fin + ri * 768 + rr * 48;
        rstd = __builtin_amdgcn_rsqf(ssf[ri * 16 + rr] * (1.f / D) + EPS);
        const float* bg = rgb + l * NG; const float* be = reb + l * NE;
        float gl4[4];
#pragma unroll
        for (int j = 0; j < 4; ++j) gl4[j] = L[j] * rstd + bg[j];
        float gm = gl4[0]; int gs = 0; if (gl4[1] > gm) { gm = gl4[1]; gs = 1; } if (gl4[2] > gm) { gm = gl4[2]; gs = 2; } if (gl4[3] > gm) { gm = gl4[3]; gs = 3; }
        const float ptop = 1.f / (__expf(gl4[0] - gm) + __expf(gl4[1] - gm) + __expf(gl4[2] - gm) + __expf(gl4[3] - gm));
        float v0 = -INFINITY, v1 = -INFINITY; int i0 = 0, i1 = 0;
#pragma unroll
        for (int i = 0; i < EPG; ++i) { const float v = L[16 + gs * EPG + i] * rstd + be[gs * EPG + i];
            if (v > v0) { v1 = v0; i1 = i0; v0 = v; i0 = i; } else if (v > v1) { v1 = v; i1 = i; } }
        const float ex = __expf(v1 - v0), inv = 1.f / (1.f + ex); g0 = inv * ptop; g1 = ex * inv * ptop;
        e0 = gs * EPG + i0; e1 = gs * EPG + i1;
        k0 = __hip_atomic_fetch_add(hist + e0, 1u, __ATOMIC_RELAXED, __HIP_MEMORY_SCOPE_WORKGROUP);
        k1 = __hip_atomic_fetch_add(hist + e1, 1u, __ATOMIC_RELAXED, __HIP_MEMORY_SCOPE_WORKGROUP);
    }
    __syncthreads();
    if (tid < 32) { const unsigned c = hist[tid]; hist[32 + tid] = c ? __hip_atomic_fetch_add(ctl + CW_CNT + (cl * 32 + tid) * 64, c, RLX_AGENT) : 0u; }
    __syncthreads();
    if (tid < nrows) {
        const unsigned p0 = hist[32 + e0] + k0, p1 = hist[32 + e1] + k1;
        LTOK[(size_t)e0 * CAP + p0] = tok; LGATE[(size_t)e0 * CAP + p0] = g0; LRSTD[(size_t)e0 * CAP + p0] = rstd;
        LTOK[(size_t)e1 * CAP + p1] = tok | (int)0x80000000; LGATE[(size_t)e1 * CAP + p1] = g1; LRSTD[(size_t)e1 * CAP + p1] = rstd;
    }
    __syncthreads();
}

struct Args { const float* in[17]; float* out; unsigned char* ws; int ph_lo, ph_hi; };
static_assert(sizeof(Args) == 17 * 8 + 8 + 8 + 8, "Args has no padding");
__device__ __forceinline__ void host_ptrs(unsigned char*& ws, const float*& wg, const float*& wu, const float*& wd) {
    const __attribute__((address_space(4))) char* ka = (const __attribute__((address_space(4))) char*)__builtin_amdgcn_kernarg_segment_ptr(); asm volatile("" : "+s"(ka));
    const __attribute__((address_space(4))) Args* a = (const __attribute__((address_space(4))) Args*)ka;
    ws = a->ws; wg = a->in[13]; wu = a->in[14]; wd = a->in[15];
}

__device__ __forceinline__ bool tail_fill_ok(int nu, int G) { return G == 256 && nu > 2 * G + 8 && nu <= 3 * G - 64; }
struct L1Split { int n1, c3, c8; };
__device__ __forceinline__ int dense_units(int nwg, int G, int c) { return c < nwg ? (nwg - 1 - c) / G + 1 : 0; }
__device__ __forceinline__ L1Split l1_split(int vcu, int G, int c) {
    L1Split s; s.n1 = (3 * 8192 - vcu + G - 1) / G;
    const int cap3 = dense_units((M / 256) * (D / 256), G, c) * 16, cap8 = dense_units((M / 256) * (3 * D / 256), G, c) * 8;
    s.c3 = s.n1 < cap3 ? s.n1 : cap3; const int r = s.n1 - s.c3; s.c8 = r < cap8 ? r : cap8; return s;
}

__global__ void __launch_bounds__(NWAVES * 64, 2) fwd_kernel(Args args) {
    extern __shared__ __attribute__((aligned(16))) unsigned char lds_raw[];
    asm volatile("s_nop 0" ::: "memory");
    Frame Fr;
    Fr.lds = (LAS unsigned char*)lds_raw;
    Fr.tid = threadIdx.x; Fr.lane = Fr.tid & 63; Fr.wave = __builtin_amdgcn_readfirstlane(Fr.tid >> 6);
    Fr.G = gridDim.x; { const int bx = blockIdx.x; Fr.vcu = (Fr.G % 8 == 0) ? (bx % 8) * (Fr.G / 8) + bx / 8 : bx; }
    volatile LAS unsigned* MISC = (volatile LAS unsigned*)(Fr.lds + MISC_OFF);
    LAS int* gtab = (LAS int*)(Fr.lds + GTAB_OFF);
    unsigned char* ws = args.ws;
    gu32* ctl = (gu32*)(ws + WS_CTL);
    const float* x = args.in[0]; const float* meta_tok = args.in[1]; const float* norm_mix_g = args.in[2]; const float* norm_ffn_g = args.in[3];
    const float* conv_w_in = args.in[4]; const float* conv_w = args.in[5]; const float* conv_w_out = args.in[6]; const float* attn_w_qkv = args.in[7]; const float* attn_w_out = args.in[8];
    const float* rgw = args.in[9]; const float* rgb = args.in[10]; const float* rew = args.in[11]; const float* reb = args.in[12];
    const float* moe_w_gate = args.in[13]; const float* moe_w_up = args.in[14]; const float* moe_w_down = args.in[15]; const float* final_g = args.in[16];
    float* out = args.out;
    bf16* WIN0 = (bf16*)(ws + WS_WIN0); bf16* WOUT0 = (bf16*)(ws + WS_WOUT0); bf16* WQKV = (bf16*)(ws + WS_WQKV); bf16* WOUT1 = (bf16*)(ws + WS_WOUT1);
    bf16* RW = (bf16*)(ws + WS_RW); bf16* XN = (bf16*)(ws + WS_XN);
    bf16* R0 = (bf16*)(ws + WS_R0); bf16* R1 = (bf16*)(ws + WS_R1); bf16* R2 = (bf16*)(ws + WS_R2);
    bf16* Hs = (bf16*)(ws + WS_H); bf16* HG = (bf16*)(ws + WS_HG); int* LTOK = (int*)(ws + WS_LTOK); float* LGATE = (float*)(ws + WS_LGATE); float* LRSTD = (float*)(ws + WS_LRSTD); float* MSCR = (float*)(ws + WS_MSCR);

    for (int u = Fr.tid; u < (LDS_BYTES - LDSCTL_OFF) / 4; u += NWAVES * 64) ((LAS unsigned*)(Fr.lds + LDSCTL_OFF))[u] = 0u;
    __syncthreads();
    XcdBarrier bar; bar.bar = (unsigned*)(ctl + CW_BAR); bar.x = 0; bar.st = nullptr;
    if (MK_N_LAUNCHES == 1) bar = xcd_barrier_post((unsigned*)(ctl + CW_BAR), MISC + 8);
#define GRID_BAR() do { if (MK_N_LAUNCHES == 1) xcd_barrier(bar); } while (0)
    const int lo = args.ph_lo, hi = args.ph_hi;
#define IN(k) (lo <= (k) && (k) < hi)
#define REP(k) for (int rep_ = 0; rep_ < 1 + ((PROBE_DUP >> (k)) & 1); ++rep_)
#define BOTH(k) (IN(k) && IN((k) + 1))
    const int NGW = Fr.G * NWAVES;
#define gw (Fr.vcu * NWAVES + Fr.wave)
#define lane (Fr.lane)

    if (IN(0)) {
        Fr.refresh();
        REP(0) {
        LAS float* scr = (LAS float*)(Fr.lds + Fr.wave * 16896);
        constexpr int I_IN = 32 * 96, I_OUT = 32 * 32;
        constexpr int NITEMS = 2 * I_IN + 2 * I_OUT;
        auto item_of = [=](int r) -> TrItem {
            TrItem t; t.mul = 0.f;
            if (r < I_IN) { const int kb = r / 96, n0 = (r % 96) * 64; int drow;
                if (n0 < D) drow = n0; else if (n0 < 2 * D) drow = D + pair_row(n0 - D, 0); else drow = D + pair_row(n0 - 2 * D, 1);
                t.src = conv_w_in + (size_t)kb * 64 * (3 * D) + n0; t.N = 3 * D; t.dst = (unsigned char*)(WIN0 + (size_t)drow * D + kb * 64); t.K = D; return t; } r -= I_IN;
            if (r < I_IN) { const int kb = r / 192, n0 = (r % 192) * 32; t.src = attn_w_qkv + (size_t)kb * 128 * (3 * D) + n0; t.N = 3 * D; t.dst = (unsigned char*)WQKV + (size_t)n0 * D + kb * 128; t.K = D; t.mul = 16.f; return t; } r -= I_IN;
            if (r < I_OUT) { const int kb = r / 32, n0 = (r % 32) * 64; t.src = conv_w_out + (size_t)kb * 64 * D + n0; t.N = D; t.dst = (unsigned char*)(WOUT0 + (size_t)n0 * D + kb * 64); t.K = D; return t; } r -= I_OUT;
            { const int kb = r / 64, n0 = (r % 64) * 32; t.src = attn_w_out + (size_t)kb * 128 * D + n0; t.N = D; t.dst = (unsigned char*)WOUT1 + (size_t)n0 * D + kb * 128; t.K = D; t.mul = 16.f; return t; }
        };
        if (gw < NITEMS) {
            f32x4 va[16], vb[16]; TrItem ia = item_of(gw), ib = ia;
#define TR_LOAD(it_, v_) do { if ((it_).mul == 0.f) tr_load(it_, v_, lane); else tr8_load(it_, v_, lane); } while (0)
#define TR_FINISH(it_, v_) do { if ((it_).mul == 0.f) tr_finish(it_, v_, scr, lane); else tr8_finish(it_, v_, scr, lane); } while (0)
            TR_LOAD(ia, va);
            for (int it = gw; it < NITEMS; it += 2 * NGW) {
                const bool hb = it + NGW < NITEMS; if (hb) { ib = item_of(it + NGW); TR_LOAD(ib, vb); }
                TR_FINISH(ia, va);
                if (!hb) break;
                const bool ha = it + 2 * NGW < NITEMS; if (ha) { ia = item_of(it + 2 * NGW); TR_LOAD(ia, va); }
                TR_FINISH(ib, vb);
                if (!ha) break;
            }
#undef TR_LOAD
#undef TR_FINISH
        }
        for (int idx = blockIdx.x * (NWAVES * 64) + Fr.tid; idx < 2 * 48 * D; idx += Fr.G * NWAVES * 64) {
            const int l = idx / (48 * D), j = (idx / D) % 48, k = idx % D;
            float w = 0.f; if (j < NG) w = rgw[((size_t)l * D + k) * NG + j]; else if (j >= 16) w = rew[((size_t)l * D + k) * NE + (j - 16)];
            w *= norm_ffn_g[(size_t)l * D + k];
            const unsigned hb = pk2(w, 0.f) & 0xffffu; const float lw = w - bf2f((unsigned short)hb);
            RW[(size_t)l * 2 * 48 * D + (size_t)j * D + k] = (bf16)hb; RW[(size_t)l * 2 * 48 * D + (size_t)(48 + j) * D + k] = (bf16)(pk2(lw, 0.f) & 0xffffu);
        }
        {
#define P0_LOAD(m_, v_) do { const float* src_ = (m_) < M ? x + (size_t)(m_) * D : meta_tok + (size_t)((m_) - M) * D; _Pragma("unroll") for (int j = 0; j < 8; ++j) v_[j] = *((const f32x4*)src_ + lane + 64 * j); } while (0)
            f32x4 va[8], vb[8];
            if (gw < MT) P0_LOAD(gw, va);
            for (int m = gw; m < MT; m += 2 * NGW) {
                const int m1 = m + NGW, m2 = m + 2 * NGW;
                if (m1 < MT) P0_LOAD(m1, vb);
                rms_store_bf16(va, norm_mix_g, XN + (size_t)m * D, lane);
                if (m1 >= MT) break;
                if (m2 < MT) P0_LOAD(m2, va);
                rms_store_bf16(vb, norm_mix_g, XN + (size_t)m1 * D, lane);
            }
#undef P0_LOAD
        }
        }
        if (BOTH(0)) GRID_BAR();
    }
    if (IN(1)) {
        Fr.refresh();
        REP(1) {
        { float* ms = MSCR; auto epi = [=](int i, int n, float v) { ms[i * (3 * D) + n] = v; }; meta_gemm(Fr, XN + (size_t)M * D, WIN0, 3 * D, D, epi); }
        pg8::DenseOrder S; S.init(XN, WIN0 + (size_t)D * D, M, 2 * D, D, Fr.G, (int)blockIdx.x);
        pg8::EpiCH E{R1};
        HostJob hj{0, Fr.vcu, Fr.G, 0, (3 * 8192 - Fr.vcu + Fr.G - 1) / Fr.G};
        host_build_table(hj, Fr.lds, Fr.tid);
        const int hd = pg8::gemm_phase<pg8::EpiCH, pg8::DenseOrder, true, false, true>(Fr.lds, S, E, &hj);
        (void)hd;
        }
        if (BOTH(1)) GRID_BAR();
    }
    if (IN(2)) {
        Fr.refresh();
        REP(2) {
        if (blockIdx.x < NMETA) { const int i = blockIdx.x;
            for (int c = Fr.tid; c < D; c += NWAVES * 64) {
                float y = 0.f;
#pragma unroll
                for (int kk = 0; kk < 3; ++kk) { const int ii = i - 2 + kk; if (ii >= 0) { const float cv = MSCR[ii * (3 * D) + D + pair_row(c, 0)], hv = MSCR[ii * (3 * D) + D + pair_row(c, 1)]; y += conv_w[kk * D + c] * bf2f((unsigned short)(pk2(cv * hv, 0.f) & 0xffffu)); } }
                const float bgv = bf2f((unsigned short)(pk2(MSCR[i * (3 * D) + c], 0.f) & 0xffffu));
                R2[(size_t)(M + i) * D + c] = (bf16)(pk2(bgv * y, 0.f) & 0xffffu); } }
        pg8::DenseOrder S; S.init(XN, WIN0, M, D, D, Fr.G, (int)blockIdx.x);
        pg8::EpiGateConv E{R1, R2, conv_w, MSCR};
        int hstart; { pg8::DenseOrder S1; S1.init(XN, WIN0 + (size_t)D * D, M, 2 * D, D, Fr.G, (int)blockIdx.x); pg8::Unit uu; int nu1 = 0; while (S1.next(nu1, uu)) ++nu1; hstart = nu1 * (D / 128); }
        HostJob hj{0, Fr.vcu, Fr.G, 0, (3 * 8192 - Fr.vcu + Fr.G - 1) / Fr.G};
        if (hstart > hj.n) hstart = hj.n;
        hj.i0 = hstart;
        int hd = 0;
        if (hj.i0 < hj.n) { HostJob h2 = hj; h2.n = hj.n - hj.i0; h2.first = hj.first + hj.i0 * hj.stride; h2.i0 = 0; host_build_table(h2, Fr.lds, Fr.tid); hd = pg8::gemm_phase<pg8::EpiGateConv, pg8::DenseOrder, true, false, true>(Fr.lds, S, E, &h2); }
        else pg8::gemm_phase<pg8::EpiGateConv, pg8::DenseOrder, true>(Fr.lds, S, E);
        Fr.refresh();
        host_leftover(hj, hj.i0 + hd, (LAS float*)(Fr.lds + Fr.wave * 16896), Fr.wave, lane);
        }
        if (BOTH(2)) GRID_BAR();
    }
    if (IN(3)) {
        Fr.refresh();
        REP(3) {
        { bf16* hs = Hs; const float* mt = meta_tok; auto epi = [=](int i, int n, float v) { hs[(size_t)(M + i) * D + n] = (bf16)(pk2(mt[i * D + n] + v, 0.f) & 0xffffu); }; meta_gemm(Fr, R2 + (size_t)M * D, WOUT0, D, D, epi); }
        pg8::DenseOrderT<true> S; S.init(R2, WOUT0, M, D, D, Fr.G, (int)blockIdx.x);
        pg8::EpiResid<true> E{x, Hs};
        const L1Split sp = l1_split(Fr.vcu, Fr.G, (int)blockIdx.x);
        HostJob hj{1, Fr.vcu, Fr.G, 0, sp.c3 > 0 ? sp.c3 : 1};
        host_build_table(hj, Fr.lds, Fr.tid);
        pg8::gemm_phase<pg8::EpiResid<true>, pg8::DenseOrderT<true>, true, false, true>(Fr.lds, S, E, &hj);
        }
        if (BOTH(3)) GRID_BAR();
    }
    if (IN(4)) {
        Fr.refresh();
        REP(4) {
        router_phase(Fr, 0, 0, MT / 16, norm_ffn_g, Hs, XN, RW, rgb, reb, ctl, LTOK, LGATE, LRSTD);
        }
        if (BOTH(4)) GRID_BAR();
    }
    if (IN(5)) {
        Fr.refresh();
        REP(5) {
        const int nu = build_tab(Fr, gtab, ctl, 0, 4);
        pg8::GroupedOrder<true> S; S.A = XN; S.Bt = ws + WS_WGU0; S.ltok = LTOK; S.tab = gtab; S.K = D; S.rowb = D; S.wscale = 0; S.NCT = 4; S.nunits = nu; S.G = Fr.G; S.c = (int)blockIdx.x; S.bstride = (size_t)1024 * D;
        S.tokl = (const LAS int*)(Fr.lds + 131072); pg8::prefill_tokens(S, (LAS int*)(Fr.lds + 131072), (LAS float*)(Fr.lds + 131072 + 6144), LRSTD, 6, false);
        pg8::EpiGateUp E{(unsigned char*)HG, (const LAS float*)(Fr.lds + 131072 + 6144)};
        pg8::gemm_phase<pg8::EpiGateUp, pg8::GroupedOrder<true>, true, true>(Fr.lds, S, E);
        if (tail_fill_ok(nu, Fr.G)) {
            const int nshort = 3 * Fr.G - nu, jw = (int)blockIdx.x - (nu - 2 * Fr.G);
            if (jw >= 0) { Fr.refresh();
                LAS float* scr = (LAS float*)(Fr.lds + Fr.wave * 16896);
                unsigned char* wsb; const float *wg_, *wu_, *wd_; host_ptrs(wsb, wg_, wu_, wd_);
                const int r0 = 80 * Fr.G + jw, rend = 96 * Fr.G, st = nshort;
                int r = r0 + Fr.wave * st;
                if (r < rend) {
                    f32x4 va[16], vb[16]; TrItem ia = moe_item(wsb, wg_, wu_, wd_, 1, r), ib = ia;
                    tr8_load(ia, va, lane);
                    for (;;) {
                        const int r1 = r + NWAVES * st; const bool hb = r1 < rend; if (hb) { ib = moe_item(wsb, wg_, wu_, wd_, 1, r1); tr8_load(ib, vb, lane); }
                        tr8_finish(ia, va, scr, lane);
                        if (!hb) break;
                        const int r2 = r1 + NWAVES * st; const bool ha = r2 < rend; if (ha) { ia = moe_item(wsb, wg_, wu_, wd_, 1, r2); tr8_load(ia, va, lane); }
                        tr8_finish(ib, vb, scr, lane);
                        if (!ha) break;
                        r = r2;
                    } } }
        }
        }
        if (BOTH(5)) GRID_BAR();
    }
    if (IN(6)) {
        Fr.refresh();
        REP(6) {
        const int nu = build_tab(Fr, gtab, ctl, 0, 8);
        pg8::GroupedOrder<false> S; S.A = HG; S.Bt = ws + WS_WD0; S.ltok = LTOK; S.tab = gtab; S.K = F; S.rowb = F; S.wscale = 0; S.NCT = 8; S.nunits = nu; S.G = Fr.G; S.c = (int)blockIdx.x; S.bstride = (size_t)D * F; S.tokl = nullptr;
        pg8::prefill_tokens(S, (LAS int*)(Fr.lds + 131072), (LAS float*)(Fr.lds + 131072 + 7168), LGATE, 7, true);
        pg8::EpiDown E{(unsigned char*)R0, (unsigned char*)R1, (const LAS int*)(Fr.lds + 131072), (const LAS float*)(Fr.lds + 131072 + 7168)};
        pg8::gemm_phase<pg8::EpiDown, pg8::GroupedOrder<false>, true, true>(Fr.lds, S, E);
        }
        if (BOTH(6)) GRID_BAR();
    }
    if (IN(7)) {
        Fr.refresh();
        {
#define P7_LOAD(m_, h_, a_, c_) do { const u32x2* hr_ = (const u32x2*)(Hs + (size_t)(m_) * D) + lane; const unsigned* y0_ = (const unsigned*)((const unsigned char*)R0 + (size_t)(m_) * D) + lane; const unsigned* y1_ = (const unsigned*)((const unsigned char*)R1 + (size_t)(m_) * D) + lane; \
            _Pragma("unroll") for (int j = 0; j < 8; ++j) { h_[j] = hr_[64 * j]; a_[j] = y0_[64 * j]; c_[j] = y1_[64 * j]; } } while (0)
#define P7_DO(m_, h_, a_, c_) do { f32x4 v[8]; u32x2* hr_ = (u32x2*)(Hs + (size_t)(m_) * D) + lane; \
            _Pragma("unroll") for (int j = 0; j < 8; ++j) { const u32x2 h = h_[j]; const f32x4 a = y8(a_[j]), c = y8(c_[j]); \
                v[j].x = (bflo(h.x) + a.x) + c.x; v[j].y = (bfhi(h.x) + a.y) + c.y; v[j].z = (bflo(h.y) + a.z) + c.z; v[j].w = (bfhi(h.y) + a.w) + c.w; \
                u32x2 w; w.x = pk2(v[j].x, v[j].y); w.y = pk2(v[j].z, v[j].w); hr_[64 * j] = w; } \
            rms_store_fp8(v, norm_mix_g + D, (unsigned char*)XN + (size_t)(m_) * D, lane); } while (0)
            u32x2 ha[8], hb[8]; unsigned aa[8], ca[8], ab[8], cb[8];
            if (gw < MT) P7_LOAD(gw, ha, aa, ca);
            for (int m = gw; m < MT; m += 2 * NGW) {
                const int m1 = m + NGW, m2 = m + 2 * NGW;
                if (m1 < MT) P7_LOAD(m1, hb, ab, cb);
                P7_DO(m, ha, aa, ca);
                if (m1 >= MT) break;
                if (m2 < MT) P7_LOAD(m2, ha, aa, ca);
                P7_DO(m1, hb, ab, cb);
            }
#undef P7_LOAD
#undef P7_DO
        }
        if (BOTH(7)) GRID_BAR();
    }
    if (IN(8)) {
        Fr.refresh();
        REP(8) {
        { bf16* kk = R1; bf16* vv = R2; auto epi = [=](int i, int n, float v) { if (n >= 2 * D) ((unsigned char*)vv)[k8_off((size_t)(M + i), n - 2 * D)] = (unsigned char)(pk4_fp8(v * 4.f, 0.f, 0.f, 0.f) & 0xffu); else if (n >= D) ((unsigned char*)kk)[k8_off((size_t)(M + i), n - D)] = (unsigned char)(pk4_fp8(v * 4.f, 0.f, 0.f, 0.f) & 0xffu); };
          meta_gemm8(Fr, (const unsigned char*)XN + (size_t)M * D, (const unsigned char*)WQKV, 3 * D, D, epi, D / 16); }
        pg8::DenseOrder S; S.init(XN, WQKV, M, 3 * D, D, Fr.G, (int)blockIdx.x, 1);
        pg8::EpiQKV E{R0, (size_t)(WS_R1 - WS_R0) / 2, QSCALE};
        const L1Split sp = l1_split(Fr.vcu, Fr.G, (int)blockIdx.x);
        HostJob hj{1, Fr.vcu + (sp.c8 > 0 ? sp.c3 : 0) * Fr.G, Fr.G, 0, sp.c8 > 0 ? sp.c8 : 1};
        host_build_table(hj, Fr.lds, Fr.tid);
        pg8::gemm_phase<pg8::EpiQKV, pg8::DenseOrder, true, true, true>(Fr.lds, S, E, &hj);
        }
        if (BOTH(8)) GRID_BAR();
    }
    if (IN(9)) {
        Fr.refresh();
        REP(9) {
        for (int t = gw; t < NB * NH * (T / 32); t += NGW) { const int bh = t >> 7, qb = t & 127;
            attn_task(Fr, bh / NH, bh % NH, qb, R0, R1, R2, XN); }
        }
        if (BOTH(9)) GRID_BAR();
    }
    if (IN(10)) {
        Fr.refresh();
        pg8::DenseOrder S; S.init(XN, WOUT1, M, D, D, Fr.G, (int)blockIdx.x, 1);
        pg8::EpiResid<false> E{Hs, Hs};
        const int nu5 = build_tab(Fr, gtab, ctl, 0, 4);
        if (tail_fill_ok(nu5, Fr.G)) pg8::gemm_phase<pg8::EpiResid<false>, pg8::DenseOrder, true, true>(Fr.lds, S, E);
        else {
        const L1Split sp = l1_split(Fr.vcu, Fr.G, (int)blockIdx.x);
        const int r10 = sp.n1 - sp.c3 - sp.c8;
        HostJob hj{1, Fr.vcu + (r10 > 0 ? sp.c3 + sp.c8 : 0) * Fr.G, Fr.G, 0, r10 > 0 ? r10 : 1};
        host_build_table(hj, Fr.lds, Fr.tid);
        const int hd = pg8::gemm_phase<pg8::EpiResid<false>, pg8::DenseOrder, true, true, true>(Fr.lds, S, E, &hj);
        Fr.refresh();
        host_leftover(hj, hd, (LAS float*)(Fr.lds + Fr.wave * 16896), Fr.wave, lane);
        }
        if (BOTH(10)) GRID_BAR();
    }
    if (IN(11)) {
        Fr.refresh();
        router_phase(Fr, 1, 1, M / 16, norm_ffn_g + D, Hs, XN, RW, rgb, reb, ctl, LTOK, LGATE, LRSTD);
        if (BOTH(11)) GRID_BAR();
    }
    if (IN(12)) {
        Fr.refresh();
        REP(12) {
        const int nu = build_tab(Fr, gtab, ctl, 1, 4);
        pg8::GroupedOrder<true> S; S.A = XN; S.Bt = ws + WS_WGU1; S.ltok = LTOK; S.tab = gtab; S.K = D; S.rowb = D; S.wscale = 0; S.NCT = 4; S.nunits = nu; S.G = Fr.G; S.c = (int)blockIdx.x; S.bstride = (size_t)1024 * D;
        S.tokl = (const LAS int*)(Fr.lds + 131072); pg8::prefill_tokens(S, (LAS int*)(Fr.lds + 131072), (LAS float*)(Fr.lds + 131072 + 6144), LRSTD, 6, false);
        pg8::EpiGateUp E{(unsigned char*)HG, (const LAS float*)(Fr.lds + 131072 + 6144)};
        pg8::gemm_phase<pg8::EpiGateUp, pg8::GroupedOrder<true>, true, true>(Fr.lds, S, E);
        }
        if (BOTH(12)) GRID_BAR();
    }
    if (IN(13)) {
        Fr.refresh();
        REP(13) {
        const int nu = build_tab(Fr, gtab, ctl, 1, 8);
        pg8::GroupedOrder<false> S; S.A = HG; S.Bt = ws + WS_WD1; S.ltok = LTOK; S.tab = gtab; S.K = F; S.rowb = F; S.wscale = 0; S.NCT = 8; S.nunits = nu; S.G = Fr.G; S.c = (int)blockIdx.x; S.bstride = (size_t)D * F; S.tokl = nullptr;
        pg8::prefill_tokens(S, (LAS int*)(Fr.lds + 131072), (LAS float*)(Fr.lds + 131072 + 7168), LGATE, 7, true);
        pg8::EpiDown E{(unsigned char*)R0, (unsigned char*)R1, (const LAS int*)(Fr.lds + 131072), (const LAS float*)(Fr.lds + 131072 + 7168)};
        pg8::gemm_phase<pg8::EpiDown, pg8::GroupedOrder<false>, true, true>(Fr.lds, S, E);
        }
        if (BOTH(13)) GRID_BAR();
    }
    if (IN(14)) {
        Fr.refresh();
        REP(14) {
        unsigned bad = 0u;
        if (MK_N_LAUNCHES == 1) bad = __hip_atomic_load(ctl + CW_BAR + XB_TMO, RLX_AGENT);
        {
#define P14_LOAD(m_, h_, a_, c_) do { const u32x2* hr_ = (const u32x2*)(Hs + (size_t)(m_) * D) + lane; const unsigned* y0_ = (const unsigned*)((const unsigned char*)R0 + (size_t)(m_) * D) + lane; const unsigned* y1_ = (const unsigned*)((const unsigned char*)R1 + (size_t)(m_) * D) + lane; \
            _Pragma("unroll") for (int j = 0; j < 8; ++j) { h_[j] = hr_[64 * j]; a_[j] = y0_[64 * j]; c_[j] = y1_[64 * j]; } } while (0)
#define P14_DO(m_, h_, a_, c_) do { f32x4 v[8]; float s = 0.f; \
            _Pragma("unroll") for (int j = 0; j < 8; ++j) { const u32x2 h = h_[j]; const f32x4 a = y8(a_[j]), c = y8(c_[j]); \
                v[j].x = (bflo(h.x) + a.x) + c.x; v[j].y = (bfhi(h.x) + a.y) + c.y; v[j].z = (bflo(h.y) + a.z) + c.z; v[j].w = (bfhi(h.y) + a.w) + c.w; \
                s += (v[j].x * v[j].x + v[j].y * v[j].y) + (v[j].z * v[j].z + v[j].w * v[j].w); } \
            float rstd = __builtin_amdgcn_rsqf(wave_sum(s) * (1.f / D) + EPS); if (bad) rstd = __builtin_nanf(""); \
            _Pragma("unroll") for (int j = 0; j < 8; ++j) { const f32x4 g = *((const f32x4*)final_g + lane + 64 * j); f32x4 o; o.x = v[j].x * rstd * g.x; o.y = v[j].y * rstd * g.y; o.z = v[j].z * rstd * g.z; o.w = v[j].w * rstd * g.w; \
                *((f32x4*)(out + (size_t)(m_) * D) + lane + 64 * j) = o; } } while (0)
            u32x2 ha[8], hb[8]; unsigned aa[8], ca[8], ab[8], cb[8];
            if (gw < M) P14_LOAD(gw, ha, aa, ca);
            for (int m = gw; m < M; m += 2 * NGW) {
                const int m1 = m + NGW, m2 = m + 2 * NGW;
                if (m1 < M) P14_LOAD(m1, hb, ab, cb);
                P14_DO(m, ha, aa, ca);
                if (m1 >= M) break;
                if (m2 < M) P14_LOAD(m2, ha, aa, ca);
                P14_DO(m1, hb, ab, cb);
            }
#undef P14_LOAD
#undef P14_DO
        }
        }
    }
#undef gw
#undef lane
#undef IN
#undef BOTH
#undef GRID_BAR
}

extern "C" void kernel_launch(void* const* d_in, const int* in_sizes, int n_in, void* d_out, int out_size, void* d_ws, size_t ws_size, hipStream_t stream) {
    static int grid = 0;
    if (grid == 0) {
        if (n_in != 17 || in_sizes[0] != M * D || out_size != M * D || ws_size < WS_END) { fprintf(stderr, "kernel_launch: unexpected shapes (n_in %d, in0 %d, out %d, ws %zu)\n", n_in, n_in > 0 ? in_sizes[0] : -1, out_size, ws_size); grid = -1; return; }
        int dev = 0, cus = 0, per_cu = 0;
        if (hipGetDevice(&dev) != hipSuccess || hipDeviceGetAttribute(&cus, hipDeviceAttributeMultiprocessorCount, dev) != hipSuccess) { grid = -1; return; }
        if (hipFuncSetAttribute((const void*)fwd_kernel, hipFuncAttributeMaxDynamicSharedMemorySize, LDS_BYTES) != hipSuccess) { fprintf(stderr, "kernel_launch: hipFuncSetAttribute failed\n"); grid = -1; return; }
        if (hipOccupancyMaxActiveBlocksPerMultiprocessor(&per_cu, (const void*)fwd_kernel, NWAVES * 64, LDS_BYTES) != hipSuccess || per_cu < 1) fprintf(stderr, "kernel_launch: occupancy query reports %d\n", per_cu);
        (void)hipGetLastError();
        grid = cus;
    }
    if (grid < 0) return;
    (void)hipMemsetAsync((char*)d_ws + WS_CTL, 0, CTL_ZERO_BYTES, stream);
    Args a{};
    for (int i = 0; i < 17; ++i) a.in[i] = (const float*)d_in[i];
    a.out = (float*)d_out; a.ws = (unsigned char*)d_ws;
    if (MK_N_LAUNCHES == 1) { a.ph_lo = 0; a.ph_hi = NPH; hipLaunchKernelGGL(fwd_kernel, dim3(grid), dim3(NWAVES * 64), LDS_BYTES, stream, a); }
    else for (int p = 0; p < NPH; ++p) { a.ph_lo = p; a.ph_hi = p + 1; hipLaunchKernelGGL(fwd_kernel, dim3(grid), dim3(NWAVES * 64), LDS_BYTES, stream, a); }
    const hipError_t le = hipPeekAtLastError();
    if (le != hipSuccess) fprintf(stderr, "kernel_launch: launch failed: %s\n", hipGetErrorName(le));
}
```
